# Optimizing an MI355X kernel written in HIP

```python
import math
import jax, jax.numpy as jnp
from jax import lax
import numpy as np

D_MODEL = 2048
BATCH = 2
SEQ = 8192
DEPTH = 2

N_HEADS = 16
N_KV_HEADS = 4
HEAD_DIM = D_MODEL // N_HEADS
GROUP = N_HEADS // N_KV_HEADS
QKV_DIM = (N_HEADS + 2 * N_KV_HEADS) * HEAD_DIM
WINDOW = 128
BLOCK = 128
KEY_SPAN = BLOCK + 2 * WINDOW
NUM_BUCKETS = 32
MAX_DISTANCE = 128
POOL_WINDOWS = (2, 4, 8, 16)
N_POOL_GROUPS = len(POOL_WINDOWS)
POOL_GROUP_DIM = D_MODEL // N_POOL_GROUPS
D_FF = 5632
N_EXPERTS = 8
TOP_K = 2
D_FF_EXPERT = 7168
EPS = 1e-6
NEG_INF = -1e30

kernel_name = "hybrid_window_gqa_pool_moe_encoder"


def rms_norm(x, g):
    xf = x.astype(jnp.float32)
    y = xf * lax.rsqrt(jnp.mean(xf * xf, axis=-1, keepdims=True) + EPS) * g.astype(jnp.float32)
    return y.astype(x.dtype)


def t5_bucket(rel):
    half = NUM_BUCKETS // 2
    ret = jnp.where(rel > 0, half, 0)
    n = jnp.abs(rel)
    max_exact = half // 2
    nf = jnp.maximum(n, 1).astype(jnp.float32)
    large = max_exact + (jnp.log(nf / max_exact) / math.log(MAX_DISTANCE / max_exact)
                         * (half - max_exact)).astype(jnp.int32)
    large = jnp.minimum(large, half - 1)
    return ret + jnp.where(n < max_exact, n, large)


def window_attention(h, w_qkv, q_gain, k_gain, sink, w_o, rel_bias):
    B, S, _ = h.shape
    nb = S // BLOCK
    qkv = h @ w_qkv
    q = qkv[..., :N_HEADS * HEAD_DIM].reshape(B, S, N_KV_HEADS, GROUP, HEAD_DIM)
    k = qkv[..., N_HEADS * HEAD_DIM:(N_HEADS + N_KV_HEADS) * HEAD_DIM].reshape(B, S, N_KV_HEADS, HEAD_DIM)
    v = qkv[..., (N_HEADS + N_KV_HEADS) * HEAD_DIM:].reshape(B, S, N_KV_HEADS, HEAD_DIM)
    q = rms_norm(q, q_gain)
    k = rms_norm(k, k_gain)

    def band(t):
        tp = jnp.pad(t, ((0, 0), (WINDOW, WINDOW), (0, 0), (0, 0)))
        tb = tp.reshape(B, nb + 2, BLOCK, N_KV_HEADS, HEAD_DIM)
        return jnp.concatenate([tb[:, :-2], tb[:, 1:-1], tb[:, 2:]], axis=2)

    kw, vw = band(k), band(v)
    qb = q.reshape(B, nb, BLOCK, N_KV_HEADS, GROUP, HEAD_DIM)
    logits = jnp.einsum('bnqhgd,bnkhd->bnhgqk', qb, kw).astype(jnp.float32) * (HEAD_DIM ** -0.5)

    qi = jnp.arange(BLOCK)[:, None]
    kj = jnp.arange(KEY_SPAN)[None, :]
    rel = kj - WINDOW - qi
    bias = rel_bias.astype(jnp.float32)[t5_bucket(rel)]
    bias = jnp.transpose(bias, (2, 0, 1)).reshape(N_KV_HEADS, GROUP, BLOCK, KEY_SPAN)
    key_pos = jnp.arange(nb)[:, None] * BLOCK - WINDOW + jnp.arange(KEY_SPAN)[None, :]
    valid = (jnp.abs(rel) <= WINDOW)[None] & ((key_pos >= 0) & (key_pos < S))[:, None, :]

    logits = jnp.where(valid[None, :, None, None], logits + bias[None, None], NEG_INF)
    sink_b = sink.astype(jnp.float32).reshape(N_KV_HEADS, GROUP)[None, None, :, :, None, None]
    m = jnp.maximum(jnp.max(logits, axis=-1, keepdims=True), sink_b)
    p = jnp.exp(logits - m)
    w = p / (jnp.sum(p, axis=-1, keepdims=True) + jnp.exp(sink_b - m))
    out = jnp.einsum('bnhgqk,bnkhd->bnqhgd', w.astype(vw.dtype), vw)
    return out.reshape(B, S, N_HEADS * HEAD_DIM) @ w_o


def multiscale_pool(h, w_in, w_group, scale, w_out):
    B, S, _ = h.shape
    u = (h @ w_in).astype(jnp.float32)
    c = jnp.pad(jnp.cumsum(u, axis=1), ((0, 0), (1, 0), (0, 0)))
    t = jnp.arange(S)
    diffs = []
    for g, win in enumerate(POOL_WINDOWS):
        sl = slice(g * POOL_GROUP_DIM, (g + 1) * POOL_GROUP_DIM)
        lo = jnp.clip(t - win // 2, 0, S)
        hi = jnp.clip(t + win // 2, 0, S)
        cg = c[:, :, sl]
        mean = (cg[:, hi] - cg[:, lo]) / (hi - lo).astype(jnp.float32)[:, None]
        diffs.append(mean - u[:, :, sl])
    d = jnp.stack(diffs, axis=2).astype(h.dtype)
    y = jnp.einsum('bsgc,gce->bsge', d, w_group).reshape(B, S, D_MODEL) * scale
    return y @ w_out


def swiglu(t, wg, wu, wd):
    return (jax.nn.silu(t @ wg) * (t @ wu)) @ wd


def moe_swiglu(h, router_w, router_b, w_gate, w_up, w_down):
    B, S, D = h.shape
    t = h.reshape(B * S, D)
    logits = (t @ router_w).astype(jnp.float32) + router_b.astype(jnp.float32)
    top_v, top_i = lax.top_k(logits, TOP_K)
    top_w = jax.nn.softmax(top_v, axis=-1)
    gates = jnp.sum(jax.nn.one_hot(top_i, N_EXPERTS, dtype=jnp.float32) * top_w[..., None], axis=1)
    y = jnp.zeros_like(t)
    for e in range(N_EXPERTS):
        y = y + gates[:, e:e + 1].astype(t.dtype) * swiglu(t, w_gate[e], w_up[e], w_down[e])
    return y.reshape(B, S, D)


def setup_inputs(seed: int = 0) -> dict:
    key = jax.random.key(seed)
    ks = jax.random.split(key, 24)
    n_a = (DEPTH + 1) // 2
    n_b = DEPTH // 2
    f32 = jnp.float32

    def dense(k, shape, fan_in):
        return jax.random.normal(k, shape, f32) * fan_in ** -0.5

    def gain(k, shape, s=0.02):
        return 1.0 + s * jax.random.normal(k, shape, f32)

    return {
        "x": jax.random.normal(ks[0], (BATCH, SEQ, D_MODEL), f32),
        "mix_norm": gain(ks[1], (DEPTH, D_MODEL)),
        "ffn_norm": gain(ks[2], (DEPTH, D_MODEL)),
        "rel_bias": 0.5 * jax.random.normal(ks[3], (NUM_BUCKETS, N_HEADS), f32),
        "attn_w_qkv": dense(ks[4], (n_a, D_MODEL, QKV_DIM), D_MODEL),
        "attn_q_gain": gain(ks[5], (n_a, HEAD_DIM)),
        "attn_k_gain": gain(ks[6], (n_a, HEAD_DIM)),
        "attn_sink": jax.random.normal(ks[7], (n_a, N_HEADS), f32),
        "attn_w_o": dense(ks[8], (n_a, N_HEADS * HEAD_DIM, D_MODEL), N_HEADS * HEAD_DIM),
        "ffn_w_gate": dense(ks[9], (n_a, D_MODEL, D_FF), D_MODEL),
        "ffn_w_up": dense(ks[10], (n_a, D_MODEL, D_FF), D_MODEL),
        "ffn_w_down": dense(ks[11], (n_a, D_FF, D_MODEL), D_FF),
        "pool_w_in": dense(ks[12], (n_b, D_MODEL, D_MODEL), D_MODEL),
        "pool_w_group": dense(ks[13], (n_b, N_POOL_GROUPS, POOL_GROUP_DIM, POOL_GROUP_DIM), POOL_GROUP_DIM),
        "pool_scale": gain(ks[14], (n_b, D_MODEL), 0.1),
        "pool_w_out": dense(ks[15], (n_b, D_MODEL, D_MODEL), D_MODEL),
        "moe_router_w": dense(ks[16], (n_b, D_MODEL, N_EXPERTS), D_MODEL),
        "moe_router_b": 0.01 * jax.random.normal(ks[17], (n_b, N_EXPERTS), f32),
        "moe_w_gate": dense(ks[18], (n_b, N_EXPERTS, D_MODEL, D_FF_EXPERT), D_MODEL),
        "moe_w_up": dense(ks[19], (n_b, N_EXPERTS, D_MODEL, D_FF_EXPERT), D_MODEL),
        "moe_w_down": dense(ks[20], (n_b, N_EXPERTS, D_FF_EXPERT, D_MODEL), D_FF_EXPERT),
    }


def reference(x, mix_norm, ffn_norm, rel_bias, attn_w_qkv, attn_q_gain, attn_k_gain, attn_sink,
              attn_w_o, ffn_w_gate, ffn_w_up, ffn_w_down, pool_w_in, pool_w_group, pool_scale,
              pool_w_out, moe_router_w, moe_router_b, moe_w_gate, moe_w_up, moe_w_down):
    for i in range(DEPTH):
        j = i // 2
        h = rms_norm(x, mix_norm[i])
        if i % 2 == 0:
            x = x + window_attention(h, attn_w_qkv[j], attn_q_gain[j], attn_k_gain[j],
                                     attn_sink[j], attn_w_o[j], rel_bias)
            h = rms_norm(x, ffn_norm[i])
            x = x + swiglu(h, ffn_w_gate[j], ffn_w_up[j], ffn_w_down[j])
        else:
            x = x + multiscale_pool(h, pool_w_in[j], pool_w_group[j], pool_scale[j], pool_w_out[j])
            h = rms_norm(x, ffn_norm[i])
            x = x + moe_swiglu(h, moe_router_w[j], moe_router_b[j], moe_w_gate[j],
                               moe_w_up[j], moe_w_down[j])
    return x
```

```cpp
#include <hip/hip_runtime.h>
#include <cstdio>
#include <cstdint>

#ifndef PROBE_MASK
#define PROBE_MASK (0)
#endif
#ifndef ACTM_PITCH
#define ACTM_PITCH 8192
#endif
#ifndef MK_N_LAUNCHES
#define MK_N_LAUNCHES 1
#endif

#define GAS __attribute__((address_space(1)))
#define LAS __attribute__((address_space(3)))
typedef unsigned short bf16_t;
typedef short bf16x8 __attribute__((ext_vector_type(8)));
typedef short s16x4 __attribute__((ext_vector_type(4)));
typedef float f32x2 __attribute__((ext_vector_type(2)));
typedef float f32x4 __attribute__((ext_vector_type(4)));
typedef float f32x16 __attribute__((ext_vector_type(16)));
typedef unsigned u32x2 __attribute__((ext_vector_type(2)));
typedef unsigned u32x4 __attribute__((ext_vector_type(4)));
typedef __bf16 bf16x2v __attribute__((ext_vector_type(2)));
typedef GAS unsigned gu32;
typedef int i32x4 __attribute__((ext_vector_type(4)));
typedef int i32x8 __attribute__((ext_vector_type(8)));

__device__ __forceinline__ unsigned pk2(float lo, float hi) { f32x2 v = {lo, hi}; bf16x2v b = __builtin_convertvector(v, bf16x2v); return __builtin_bit_cast(unsigned, b); }
__device__ __forceinline__ unsigned pk4_fp8(float a, float b, float c, float d) {
    a = __builtin_amdgcn_fmed3f(a, -448.f, 448.f); b = __builtin_amdgcn_fmed3f(b, -448.f, 448.f); c = __builtin_amdgcn_fmed3f(c, -448.f, 448.f); d = __builtin_amdgcn_fmed3f(d, -448.f, 448.f);
    int w = __builtin_amdgcn_cvt_pk_fp8_f32(a, b, 0, false); w = __builtin_amdgcn_cvt_pk_fp8_f32(c, d, w, true); return (unsigned)w; }
__device__ __forceinline__ float bf_lo(unsigned w) { return __uint_as_float(w << 16); }
__device__ __forceinline__ float bf_hi(unsigned w) { return __uint_as_float(w & 0xffff0000u); }

constexpr int BATCH = 2, SEQ = 8192, T = BATCH * SEQ, D = 2048, NH = 16, NKV = 4, HD = 128, QKVD = 3072;
constexpr int FF = 5632, NE = 8, FFE = 7168;
constexpr int FFEP = ACTM_PITCH;
constexpr int SLOTS_MAX = 2 * T + NE * 256;
constexpr float EPS = 1e-6f;
constexpr float LOG2E = 1.4426950408889634f;
constexpr float W8_SCALE = 128.f, W8_INV = 1.f / 128.f;

__host__ __device__ __forceinline__ unsigned tile_off16k(int r7, int c7) { const int st = (r7 >> 4) * 2 + (c7 >> 6), ob = (r7 & 15) * 64 + (c7 & 63); return (unsigned)(st * 1024 + (ob ^ (((ob >> 9) & 1) << 5))); }
__host__ __device__ __forceinline__ size_t tiled_off(int row, int cb, int nkt) { return ((size_t)((row >> 7) * nkt + (cb >> 7)) << 14) + tile_off16k(row & 127, cb & 127); }
__host__ __device__ __forceinline__ int inv_perm32(int w) { return 16 * ((w >> 2) & 1) + 4 * (w >> 3) + (w & 3); }

namespace pg8 {
constexpr int BM = 256, BK = 64, HALF = 128, HTB = HALF * BK * 2, STAGE_BYTES = 8 * HTB, NXCD = 8;
__host__ __device__ __forceinline__ int lds_byte(int r, int c) { const int st = (r >> 4) * 2 + (c >> 5), rr = r & 15, cc = c & 31, ob = rr * 64 + cc * 2; return st * 1024 + (ob ^ (((ob >> 9) & 1) << 5)); }
__host__ __device__ __forceinline__ void stage_rc(int b, int& R, int& C) { const int st = b / 1024, sb = b % 1024, swz = sb ^ (((sb >> 9) & 1) << 5); R = (st >> 1) * 16 + swz / 64; C = (st & 1) * 32 + (swz % 64) / 2; }
__host__ __device__ __forceinline__ int perm32(int rho) { const int n = rho >> 4, i = rho & 15; return 8 * (i >> 2) + 4 * n + (i & 3); }

struct Unit { int pm, pn, aux; const char* a; const char* b; };
struct Gemm { int lda, ldb, nt, nktA, nktB; };

template <int WGM> struct TileOrder {
    int nM, nN, nwg, G, c;
    __device__ __forceinline__ void init(int nM_, int nN_, int G_, int c_) { nM = nM_; nN = nN_; nwg = nM * nN; G = G_; c = c_; }
    __device__ __forceinline__ bool tile(int i, int& pm, int& pn) const {
        const long L = (long)i * G + c; if (L >= nwg) return false;
        int wgid = (int)L; { const int q = nwg / NXCD, r = nwg % NXCD, xcd = wgid % NXCD, off = wgid / NXCD; wgid = (xcd < r ? xcd * (q + 1) : r * (q + 1) + (xcd - r) * q) + off; }
        const int nig = WGM * nN, gid = wgid / nig, fm = gid * WGM, gsz = (nM - fm) < WGM ? (nM - fm) : WGM;
        pm = fm + ((wgid % nig) % gsz); pn = (wgid % nig) / gsz; return true;
    }
};
struct DenseSched {
    TileOrder<8> o; const char* A; const char* B; size_t astep, bstep;
    __device__ __forceinline__ void init(const bf16_t* A_, const bf16_t* B_, int M, int N, int lda, int ldb, int G, int c) { o.init(M / BM, N / BM, G, c); A = (const char*)A_; B = (const char*)B_; astep = (size_t)BM * lda * 2; bstep = (size_t)BM * ldb * 2; }
    __device__ __forceinline__ bool next(int i, Unit& u) const { if (!o.tile(i, u.pm, u.pn)) return false; u.a = A + (size_t)u.pm * astep; u.b = B + (size_t)u.pn * bstep; return true; }
};
struct WprodSched {
    int G, c; const char* A; const char* B;
    __device__ __forceinline__ void init(const bf16_t* A_, const bf16_t* B_, int G_, int c_) { G = G_; c = c_; A = (const char*)A_; B = (const char*)B_; }
    __device__ __forceinline__ bool next(int i, Unit& u) const { const int L = i * G + c; if (L >= 64) return false;
        const int g = L >> 4, pm = (L >> 1) & 7, pn = L & 1; u.pm = pm; u.pn = g * 2 + pn;
        u.a = A + ((size_t)pm * BM * D + (size_t)g * 512) * 2; u.b = B + ((size_t)(g * 512 + pn * BM) * 512) * 2; return true; }
};
struct MoeSched {
    TileOrder<8> o; const char* A; const char* B; size_t astep, bstep, estep; const LAS int* te;
    __device__ __forceinline__ void init(const bf16_t* A_, const bf16_t* B_, int nM, int nper, int lda, int ldb, const LAS int* te_, int G, int c) {
        o.init(nM, nper / BM, G, c); A = (const char*)A_; B = (const char*)B_; astep = (size_t)BM * lda * 2; bstep = (size_t)BM * ldb * 2; estep = (size_t)nper * ldb * 2; te = te_; }
    __device__ __forceinline__ bool next(int i, Unit& u) const { if (!o.tile(i, u.pm, u.pn)) return false;
        const int e = __builtin_amdgcn_readfirstlane(te[u.pm]); u.a = A + (size_t)u.pm * astep; u.b = B + (size_t)e * estep + (size_t)u.pn * bstep; return true; }
};

struct MoeTailSched {
    int nsu, S, pm0, G, c; const char* A; const char* B; size_t astep, bstep, estep, kbytes; const LAS int* te;
    __device__ __forceinline__ void init(const bf16_t* A_, const bf16_t* B_, int pm0_, int R, int S_, int nper, int lda, int ldb, const LAS int* te_, int G_, int c_) {
        nsu = R * 8 * S_; S = S_; pm0 = pm0_; G = G_; c = c_; A = (const char*)A_; B = (const char*)B_; astep = (size_t)BM * lda * 2; bstep = (size_t)BM * ldb * 2; estep = (size_t)nper * ldb * 2; kbytes = (size_t)(FFE / 128 / S_) * 16384; te = te_; }
    __device__ __forceinline__ bool next(int i, Unit& u) const { const int L = i * G + c; if (L >= nsu) return false;
        const int ut = L / S, kp = L - ut * S; u.pm = pm0 + (ut >> 3); u.pn = ut & 7; u.aux = L;
        const int e = __builtin_amdgcn_readfirstlane(te[u.pm]); u.a = A + (size_t)u.pm * astep + (size_t)kp * kbytes; u.b = B + (size_t)e * estep + (size_t)u.pn * bstep + (size_t)kp * kbytes; return true; }
};

struct EpiBf16 {
    static constexpr bool PERM = true;
    bf16_t* O; int ldc; const float* cscale;
    __device__ __forceinline__ void operator()(const f32x4 (&acc)[2][2][4][2], const Unit& u, int wr, int wc, int fr, int fq) const {
        const int row0 = u.pm * BM + wr * 64 + fr, col0 = u.pn * BM + wc * 32 + 8 * fq;
        f32x4 sv[2][2];
#pragma unroll
        for (int bj = 0; bj < 2; ++bj)
#pragma unroll
            for (int n = 0; n < 2; ++n) sv[bj][n] = cscale ? *(const f32x4*)(cscale + col0 + bj * HALF + 4 * n) : (f32x4){1.f, 1.f, 1.f, 1.f};
#pragma unroll
        for (int ai = 0; ai < 2; ++ai)
#pragma unroll
            for (int m = 0; m < 4; ++m) { bf16_t* rowp = O + (size_t)(row0 + ai * HALF + m * 16) * ldc + col0;
#pragma unroll
                for (int bj = 0; bj < 2; ++bj) { const f32x4 v0 = acc[ai][bj][m][0] * sv[bj][0], v1 = acc[ai][bj][m][1] * sv[bj][1];
                    u32x4 w; w.x = pk2(v0[0], v0[1]); w.y = pk2(v0[2], v0[3]); w.z = pk2(v1[0], v1[1]); w.w = pk2(v1[2], v1[3]);
                    *(u32x4*)(rowp + bj * HALF) = w; } }
    }
};
__device__ __forceinline__ float swiglu1(float g, float u) { return g * u * __builtin_amdgcn_rcpf(1.0f + __builtin_amdgcn_exp2f(-LOG2E * g)); }
__device__ __forceinline__ f32x2 swiglu_pk(f32x2 g, f32x2 u, float ke, float ci) {
    const f32x2 t = g * ke; f32x2 e; e.x = __builtin_amdgcn_exp2f(t.x); e.y = __builtin_amdgcn_exp2f(t.y);
    const f32x2 d = e * ci + ci; f32x2 r; r.x = __builtin_amdgcn_rcpf(d.x); r.y = __builtin_amdgcn_rcpf(d.y);
    return (g * u) * r; }
struct EpiSwiGLU {
    static constexpr bool PERM = true;
    bf16_t* O; int ldc; int nkt;
    __device__ __forceinline__ void operator()(const f32x4 (&acc)[2][2][4][2], const Unit& u, int wr, int wc, int fr, int fq) const {
        const int row0 = u.pm * BM + wr * 64 + fr, col0 = u.pn * HALF + wc * 32 + 8 * fq;
        const unsigned toff = tile_off16k(wr * 64 + fr, (wc & 1) * 64 + 16 * fq);
#pragma unroll
        for (int ai = 0; ai < 2; ++ai)
#pragma unroll
            for (int m = 0; m < 4; ++m) { bf16_t* rowp = nkt ? (bf16_t*)((unsigned char*)O + (((size_t)((u.pm * 2 + ai) * nkt + 2 * u.pn + (wc >> 1))) << 14) + toff + m * 2048) : O + (size_t)(row0 + ai * HALF + m * 16) * ldc + col0;
                const f32x4 g0 = acc[ai][0][m][0], g1 = acc[ai][0][m][1], u0 = acc[ai][1][m][0], u1 = acc[ai][1][m][1];
                u32x4 w; w.x = pk2(swiglu1(g0[0], u0[0]), swiglu1(g0[1], u0[1])); w.y = pk2(swiglu1(g0[2], u0[2]), swiglu1(g0[3], u0[3]));
                w.z = pk2(swiglu1(g1[0], u1[0]), swiglu1(g1[1], u1[1])); w.w = pk2(swiglu1(g1[2], u1[2]), swiglu1(g1[3], u1[3]));
                *(u32x4*)rowp = w; }
    }
};
struct EpiBf16i8 {
    static constexpr bool PERM = true;
    bf16_t* O; int ldc; const float* sA; const float* sW;
    __device__ __forceinline__ void operator()(const f32x4 (&acc)[2][2][4][2], const Unit& u, int wr, int wc, int fr, int fq) const {
        const int row0 = u.pm * BM + wr * 64 + fr, col0 = u.pn * BM + wc * 32 + 8 * fq;
        f32x4 sv[2][2];
#pragma unroll
        for (int bj = 0; bj < 2; ++bj)
#pragma unroll
            for (int n = 0; n < 2; ++n) sv[bj][n] = *(const f32x4*)(sW + col0 + bj * HALF + 4 * n);
#pragma unroll
        for (int ai = 0; ai < 2; ++ai)
#pragma unroll
            for (int m = 0; m < 4; ++m) { const int row = row0 + ai * HALF + m * 16; const float ra = sA[row]; bf16_t* rowp = O + (size_t)row * ldc + col0;
#pragma unroll
                for (int bj = 0; bj < 2; ++bj) { const f32x4 v0 = __builtin_convertvector(__builtin_bit_cast(i32x4, acc[ai][bj][m][0]), f32x4) * (sv[bj][0] * ra), v1 = __builtin_convertvector(__builtin_bit_cast(i32x4, acc[ai][bj][m][1]), f32x4) * (sv[bj][1] * ra);
                    u32x4 w; w.x = pk2(v0[0], v0[1]); w.y = pk2(v0[2], v0[3]); w.z = pk2(v1[0], v1[1]); w.w = pk2(v1[2], v1[3]);
                    *(u32x4*)(rowp + bj * HALF) = w; } }
    }
};
struct EpiSwiGLUi8 {
    static constexpr bool PERM = true;
    bf16_t* O; int ldc; int nkt; const float* sA; const float* sW; int o8;
    __device__ __forceinline__ void operator()(const f32x4 (&acc)[2][2][4][2], const Unit& u, int wr, int wc, int fr, int fq) const {
        const int row0 = u.pm * BM + wr * 64 + fr, col0 = u.pn * HALF + wc * 32 + 8 * fq;
        const unsigned toff = tile_off16k(wr * 64 + fr, (wc & 1) * 64 + 16 * fq), toff8 = tile_off16k(wr * 64 + fr, wc * 32 + 8 * fq);
        const float* swp = sW + u.pn * BM + wc * 32 + 8 * fq;
        const f32x4 wg0 = *(const f32x4*)swp, wg1 = *(const f32x4*)(swp + 4), wu0 = *(const f32x4*)(swp + HALF), wu1 = *(const f32x4*)(swp + HALF + 4);
#pragma unroll
        for (int ai = 0; ai < 2; ++ai)
#pragma unroll
            for (int m = 0; m < 4; ++m) { const int row = row0 + ai * HALF + m * 16; const float ra = sA[row];
                bf16_t* rowp = nkt ? (bf16_t*)((unsigned char*)O + (((size_t)((u.pm * 2 + ai) * nkt + 2 * u.pn + (wc >> 1))) << 14) + toff + m * 2048) : O + (size_t)row * ldc + col0;
                const i32x4 ig0 = __builtin_bit_cast(i32x4, acc[ai][0][m][0]), ig1 = __builtin_bit_cast(i32x4, acc[ai][0][m][1]), iu0 = __builtin_bit_cast(i32x4, acc[ai][1][m][0]), iu1 = __builtin_bit_cast(i32x4, acc[ai][1][m][1]);
                const f32x4 g0 = __builtin_convertvector(ig0, f32x4) * wg0, g1 = __builtin_convertvector(ig1, f32x4) * wg1, u0 = __builtin_convertvector(iu0, f32x4) * wu0, u1 = __builtin_convertvector(iu1, f32x4) * wu1;
                if (o8) { const float ke = -LOG2E * ra, ci = 1.0f / (ra * ra);
                    const f32x2 a0 = swiglu_pk((f32x2){g0[0], g0[1]}, (f32x2){u0[0], u0[1]}, ke, ci), a1 = swiglu_pk((f32x2){g0[2], g0[3]}, (f32x2){u0[2], u0[3]}, ke, ci),
                                a2 = swiglu_pk((f32x2){g1[0], g1[1]}, (f32x2){u1[0], u1[1]}, ke, ci), a3 = swiglu_pk((f32x2){g1[2], g1[3]}, (f32x2){u1[2], u1[3]}, ke, ci);
                    u32x2 w8; w8.x = pk4_fp8(a0.x, a0.y, a1.x, a1.y); w8.y = pk4_fp8(a2.x, a2.y, a3.x, a3.y);
                    *(u32x2*)((unsigned char*)O + (((size_t)((u.pm * 2 + ai) * nkt + u.pn)) << 14) + toff8 + m * 2048) = w8; }
                else { const f32x4 G0 = g0 * ra, G1 = g1 * ra, U0 = u0 * ra, U1 = u1 * ra;
                u32x4 w; w.x = pk2(swiglu1(G0[0], U0[0]), swiglu1(G0[1], U0[1])); w.y = pk2(swiglu1(G0[2], U0[2]), swiglu1(G0[3], U0[3]));
                w.z = pk2(swiglu1(G1[0], U1[0]), swiglu1(G1[1], U1[1])); w.w = pk2(swiglu1(G1[2], U1[2]), swiglu1(G1[3], U1[3]));
                *(u32x4*)rowp = w; } }
    }
};
struct EpiSwiGLU8 {
    static constexpr bool PERM = true;
    unsigned char* O; int ldc; float sin; int nkt;
    __device__ __forceinline__ void operator()(const f32x4 (&acc)[2][2][4][2], const Unit& u, int wr, int wc, int fr, int fq) const {
        const int row0 = u.pm * BM + wr * 64 + fr, col0 = u.pn * HALF + wc * 32 + 8 * fq;
        const unsigned toff = tile_off16k(wr * 64 + fr, wc * 32 + 8 * fq);
#pragma unroll
        for (int ai = 0; ai < 2; ++ai)
#pragma unroll
            for (int m = 0; m < 4; ++m) { unsigned char* rowp = nkt ? O + (((size_t)((u.pm * 2 + ai) * nkt + u.pn)) << 14) + toff + m * 2048 : O + (size_t)(row0 + ai * HALF + m * 16) * ldc + col0;
                const f32x4 g0 = acc[ai][0][m][0], g1 = acc[ai][0][m][1], u0 = acc[ai][1][m][0], u1 = acc[ai][1][m][1];
                const float ke = -LOG2E * sin, ci = 1.0f / (sin * sin);
                const f32x2 a0 = swiglu_pk((f32x2){g0[0], g0[1]}, (f32x2){u0[0], u0[1]}, ke, ci), a1 = swiglu_pk((f32x2){g0[2], g0[3]}, (f32x2){u0[2], u0[3]}, ke, ci),
                            a2 = swiglu_pk((f32x2){g1[0], g1[1]}, (f32x2){u1[0], u1[1]}, ke, ci), a3 = swiglu_pk((f32x2){g1[2], g1[3]}, (f32x2){u1[2], u1[3]}, ke, ci);
                u32x2 w; w.x = pk4_fp8(a0.x, a0.y, a1.x, a1.y); w.y = pk4_fp8(a2.x, a2.y, a3.x, a3.y);
                *(u32x2*)rowp = w; }
    }
};
struct EpiRes {
    static constexpr bool PERM = false;
    const float* base; float* out; int ldc; float sc;
    __device__ __forceinline__ void operator()(const f32x4 (&acc)[2][2][4][2], const Unit& u, int wr, int wc, int fr, int fq) const {
        const int row0 = u.pm * BM + wr * 64 + fr, col0 = u.pn * BM + wc * 32 + 4 * fq;
#pragma unroll
        for (int ai = 0; ai < 2; ++ai)
#pragma unroll
            for (int m = 0; m < 4; ++m) { const size_t off = (size_t)(row0 + ai * HALF + m * 16) * ldc + col0;
#pragma unroll
                for (int bj = 0; bj < 2; ++bj)
#pragma unroll
                    for (int n = 0; n < 2; ++n) { const f32x4 bs = *(const f32x4*)(base + off + bj * HALF + n * 16); *(f32x4*)(out + off + bj * HALF + n * 16) = bs + acc[ai][bj][m][n] * sc; } }
    }
};
struct EpiRowScaleBf16 {
    static constexpr bool PERM = true;
    bf16_t* O; int ldc; const float* rscale; float sin;
    __device__ __forceinline__ void operator()(const f32x4 (&acc)[2][2][4][2], const Unit& u, int wr, int wc, int fr, int fq) const {
        const int row0 = u.pm * BM + wr * 64 + fr, col0 = u.pn * BM + wc * 32 + 8 * fq;
#pragma unroll
        for (int ai = 0; ai < 2; ++ai)
#pragma unroll
            for (int m = 0; m < 4; ++m) { const int row = row0 + ai * HALF + m * 16; const float rs = rscale[row] * sin; bf16_t* rowp = O + (size_t)row * ldc + col0;
#pragma unroll
                for (int bj = 0; bj < 2; ++bj) { const f32x4 v0 = acc[ai][bj][m][0] * rs, v1 = acc[ai][bj][m][1] * rs;
                    u32x4 w; w.x = pk2(v0[0], v0[1]); w.y = pk2(v0[2], v0[3]); w.z = pk2(v1[0], v1[1]); w.w = pk2(v1[2], v1[3]);
                    *(u32x4*)(rowp + bj * HALF) = w; } }
    }
};

struct EpiPartF32 {
    static constexpr bool PERM = true;
    float* P; const float* rscale; float sin;
    __device__ __forceinline__ void operator()(const f32x4 (&acc)[2][2][4][2], const Unit& u, int wr, int wc, int fr, int fq) const {
        float* base = P + (size_t)u.aux * 65536; const int r0 = wr * 64 + fr, c0 = wc * 32 + 8 * fq;
#pragma unroll
        for (int ai = 0; ai < 2; ++ai)
#pragma unroll
            for (int m = 0; m < 4; ++m) { const int r = r0 + ai * HALF + m * 16; const float rs = rscale[u.pm * BM + r] * sin; float* rowp = base + r * 256 + c0;
#pragma unroll
                for (int bj = 0; bj < 2; ++bj)
#pragma unroll
                    for (int n = 0; n < 2; ++n) *(f32x4*)(rowp + bj * HALF + n * 4) = acc[ai][bj][m][n] * rs; }
    }
};

__device__ __forceinline__ i32x8 cat8(bf16x8 lo, bf16x8 hi) { const i32x4 a = __builtin_bit_cast(i32x4, lo), b = __builtin_bit_cast(i32x4, hi); return __builtin_shufflevector(a, b, 0, 1, 2, 3, 4, 5, 6, 7); }
template <class Epi, class Sched, int MODE = 0  , bool ALIGN_EPI = true>
__device__ __forceinline__ void gemm_phase(LAS unsigned char* lds, const Gemm g, const Sched& S, const Epi& E) {
    const int tid = threadIdx.x, wid = __builtin_amdgcn_readfirstlane(tid >> 6), lane = tid & 63, wr = wid >> 2, wc = wid & 3, fr = lane & 15, fq = lane >> 4;
    const int nt = g.nt;
    unsigned voffA[2], voffB[2];
#pragma unroll
    for (int i = 0; i < 2; ++i) { int R, C; stage_rc(tid * 16 + i * 8192, R, C); const int Rb = Epi::PERM ? ((R & ~31) + perm32(R & 31)) : R;
        voffA[i] = g.nktA ? (unsigned)(tid * 16 + i * 8192) : (unsigned)(R * g.lda + C) * 2u; voffB[i] = g.nktB ? (unsigned)(tid * 16 + i * 8192) : (unsigned)(Rb * g.ldb + C) * 2u; }
    const size_t kstepA = g.nktA ? (size_t)16384 : (size_t)(BK * 2), kstepB = g.nktB ? (size_t)16384 : (size_t)(BK * 2);
    const size_t hstepA = g.nktA ? (size_t)g.nktA * 16384 : (size_t)HALF * g.lda * 2, hstepB = g.nktB ? (size_t)g.nktB * 16384 : (size_t)HALF * g.ldb * 2;
    const unsigned ldsw = (unsigned)wid * 1024u;
    const int aoff = lds_byte(wr * 64 + fr, fq * 8), boff = lds_byte(wc * 32 + fr, fq * 8);
#define PG8_SA(b, h) (((b) * 2 + (h)) * HTB)
#define PG8_SB(b, h) ((4 + (b) * 2 + (h)) * HTB)
#define PG8_STAGE(bufoff, gbase, voff) do { const char* _gb = (const char*)(gbase); asm volatile("" : "+s"(_gb)); _Pragma("unroll") for (int _i = 0; _i < 2; ++_i) \
        { unsigned _vo = (voff)[_i]; asm volatile("" : "+v"(_vo)); __builtin_amdgcn_global_load_lds((const unsigned*)(_gb + _vo), (LAS unsigned*)(lds + (bufoff) + ldsw + _i * 8192), 16, 0, 0); } } while (0)
#define PG8_LDA(dst, b, h) do { _Pragma("unroll") for (int m = 0; m < 4; ++m) _Pragma("unroll") for (int k = 0; k < 2; ++k) dst[m][k] = *(const LAS bf16x8*)(lds + PG8_SA(b, h) + aoff + m * 2048 + k * 1024); } while (0)
#define PG8_LDB(dst, b, h) do { _Pragma("unroll") for (int n = 0; n < 2; ++n) _Pragma("unroll") for (int k = 0; k < 2; ++k) dst[n][k] = *(const LAS bf16x8*)(lds + PG8_SB(b, h) + boff + n * 2048 + k * 1024); } while (0)
#define PG8_MMA(ai, bj, At, Bt) do { __builtin_amdgcn_s_setprio(1); _Pragma("unroll") for (int m = 0; m < 4; ++m) _Pragma("unroll") for (int n = 0; n < 2; ++n) { \
        if constexpr (MODE == 1) { asm volatile("v_mfma_f32_16x16x128_f8f6f4 %0, %1, %2, %0" : "+v"(acc[ai][bj][m][n]) : "v"(cat8(Bt[n][0], Bt[n][1])), "v"(cat8(At[m][0], At[m][1]))); } \
        else if constexpr (MODE == 2) { _Pragma("unroll") for (int k = 0; k < 2; ++k) asm volatile("v_mfma_i32_16x16x64_i8 %0, %1, %2, %0" : "+v"(acc[ai][bj][m][n]) : "v"(Bt[n][k]), "v"(At[m][k])); } \
        else { _Pragma("unroll") for (int k = 0; k < 2; ++k) acc[ai][bj][m][n] = __builtin_amdgcn_mfma_f32_16x16x32_bf16(Bt[n][k], At[m][k], acc[ai][bj][m][n], 0, 0, 0); } } \
        __builtin_amdgcn_s_setprio(0); } while (0)
#define PG8_WAIT_V(n) asm volatile("s_waitcnt vmcnt(" #n ")" ::: "memory")
#define PG8_WAIT_L(n) asm volatile("s_waitcnt lgkmcnt(" #n ")" ::: "memory")
#define PG8_BAR __builtin_amdgcn_s_barrier()
#define PG8_SCHED __builtin_amdgcn_sched_barrier(0)
    Unit cur, nxt; int ui = 0;
    if (!S.next(0, cur)) return;
    f32x4 acc[2][2][4][2];
#pragma unroll
    for (int a = 0; a < 2; ++a)
#pragma unroll
        for (int b = 0; b < 2; ++b)
#pragma unroll
            for (int m = 0; m < 4; ++m)
#pragma unroll
                for (int n = 0; n < 2; ++n) acc[a][b][m][n] = (f32x4){0.f, 0.f, 0.f, 0.f};
    bf16x8 At[4][2], B0[2][2], B1[2][2];
    const char* cA = cur.a; const char* cB = cur.b;
    PG8_STAGE(PG8_SB(0, 0), cB, voffB); PG8_STAGE(PG8_SB(0, 1), cB + hstepB, voffB); PG8_STAGE(PG8_SA(0, 0), cA, voffA); PG8_STAGE(PG8_SA(0, 1), cA + hstepA, voffA);
    if (wr == 1) PG8_BAR;
    PG8_WAIT_V(2); PG8_BAR;
    PG8_STAGE(PG8_SB(1, 0), cB + kstepB, voffB); PG8_STAGE(PG8_SA(1, 0), cA + kstepA, voffA); PG8_STAGE(PG8_SB(1, 1), cB + hstepB + kstepB, voffB);
    PG8_WAIT_V(6); PG8_BAR;
    for (;;) {
        const bool has_next = S.next(ui + 1, nxt);
        const char* nA = has_next ? nxt.a : cA; const char* nB = has_next ? nxt.b : cB;
        for (int t = 0; t < nt; t += 2) {
            const bool last = (t == nt - 2);
            const char* a1 = cA + (size_t)(t + 1) * kstepA;
            const char* a2 = last ? nA : cA + (size_t)(t + 2) * kstepA; const char* b2 = last ? nB : cB + (size_t)(t + 2) * kstepB;
            const char* a3 = a2 + kstepA; const char* b3 = b2 + kstepB;
            PG8_LDB(B0, 0, 0); PG8_LDB(B1, 0, 1); PG8_SCHED; PG8_LDA(At, 0, 0); PG8_STAGE(PG8_SA(1, 1), a1 + hstepA, voffA);
            PG8_WAIT_V(8); PG8_WAIT_L(0); PG8_BAR; PG8_MMA(0, 0, At, B0); PG8_MMA(0, 1, At, B1); PG8_BAR; PG8_SCHED;
            PG8_LDA(At, 0, 1); PG8_STAGE(PG8_SB(0, 0), b2, voffB); PG8_STAGE(PG8_SB(0, 1), b2 + hstepB, voffB); PG8_STAGE(PG8_SA(0, 0), a2, voffA);
            PG8_WAIT_V(8); PG8_WAIT_L(0); PG8_BAR; PG8_MMA(1, 0, At, B0); PG8_MMA(1, 1, At, B1); PG8_BAR; PG8_SCHED;
            PG8_LDB(B0, 1, 0); PG8_LDB(B1, 1, 1); PG8_SCHED; PG8_LDA(At, 1, 0); PG8_STAGE(PG8_SA(0, 1), a2 + hstepA, voffA);
            PG8_WAIT_V(8); PG8_WAIT_L(0); PG8_BAR; PG8_MMA(0, 0, At, B0); PG8_MMA(0, 1, At, B1); PG8_BAR; PG8_SCHED;
            PG8_LDA(At, 1, 1); PG8_STAGE(PG8_SB(1, 0), b3, voffB); PG8_STAGE(PG8_SB(1, 1), b3 + hstepB, voffB); PG8_STAGE(PG8_SA(1, 0), a3, voffA);
            PG8_WAIT_V(8); PG8_WAIT_L(0); PG8_BAR; PG8_MMA(1, 0, At, B0); PG8_MMA(1, 1, At, B1); PG8_BAR; PG8_SCHED;
        }
        if constexpr (ALIGN_EPI) { if (wr == 0) PG8_BAR; }
        if constexpr (MODE != 0) asm volatile("s_nop 15\n\ts_nop 7" ::: "memory");
        E(acc, cur, wr, wc, fr, fq);
        if (!has_next) break;
#pragma unroll
        for (int a = 0; a < 2; ++a)
#pragma unroll
            for (int b = 0; b < 2; ++b)
#pragma unroll
                for (int m = 0; m < 4; ++m)
#pragma unroll
                    for (int n = 0; n < 2; ++n) acc[a][b][m][n] = (f32x4){0.f, 0.f, 0.f, 0.f};
        cur = nxt; cA = nA; cB = nB; ++ui;
        if constexpr (ALIGN_EPI) { if (wr == 1) PG8_BAR; }
    }
    PG8_WAIT_V(0);
    if constexpr (!ALIGN_EPI) { if (wr == 0) PG8_BAR; }
    PG8_BAR;
#undef PG8_SA
#undef PG8_SB
#undef PG8_STAGE
#undef PG8_LDA
#undef PG8_LDB
#undef PG8_MMA
#undef PG8_WAIT_V
#undef PG8_WAIT_L
#undef PG8_BAR
#undef PG8_SCHED
}
}

constexpr int NWAVES = 8;
constexpr int NPH = 19;
constexpr int N_LAUNCHES = MK_N_LAUNCHES;
static_assert(N_LAUNCHES == 1 || N_LAUNCHES == NPH, "MK_N_LAUNCHES must be 1 or 19");

constexpr size_t MiB = 1u << 20;
constexpr size_t WS_CTL = 0, CTL_ZERO_BYTES = 1 * MiB;
constexpr size_t WS_TAB = 1 * MiB;
constexpr size_t TAB_TE = 0, TAB_TW = 64 * 1024, TAB_CNT = 192 * 1024, TAB_SLOT = 256 * 1024, TAB_WSLOT = 384 * 1024, TAB_TILE = 640 * 1024, TAB_SA = 768 * 1024, TAB_SW = 832 * 1024;
constexpr size_t CTL_CMAX = 65536;
constexpr size_t WS_WQKV = 3 * MiB;
constexpr size_t WS_WO = WS_WQKV + (size_t)QKVD * D * 2;
constexpr size_t WS_WGU = WS_WO + (size_t)D * D * 2;
constexpr size_t WS_WD = WS_WGU + (size_t)2 * FF * D * 2;
constexpr size_t WS_WIN = WS_WD + (size_t)D * FF * 2;
constexpr size_t WS_WG = WS_WIN + (size_t)D * D * 2;
constexpr size_t WS_WOUT = WS_WG + (size_t)4 * 512 * 512 * 2;
constexpr size_t WS_WMGU = WS_WOUT + (size_t)D * D * 2;
constexpr size_t WS_WMD = WS_WMGU + (size_t)NE * 2 * FFE * D * 2;
constexpr size_t WS_H = WS_WMD + (size_t)NE * D * FFE * 2;
constexpr size_t WS_BIG = WS_H + (size_t)T * D * 2;
constexpr size_t BIG_BYTES = (size_t)SLOTS_MAX * FFE * 2;
static_assert((size_t)SLOTS_MAX * FFEP <= 288 * MiB && 288 * MiB + 64 * MiB <= BIG_BYTES, "ACTM + partials fit");
constexpr size_t WS_QKV = WS_BIG, WS_AO = WS_BIG + (size_t)T * QKVD * 2, WS_ACT = WS_AO + (size_t)T * D * 2;
constexpr size_t WS_U = WS_BIG, WS_DD = WS_U + (size_t)T * D * 2, WS_Y = WS_DD + (size_t)T * D * 2;
constexpr size_t WS_ACTM = WS_BIG;
constexpr size_t WS_PART = WS_BIG + 288 * MiB;
constexpr size_t WS_WGU8 = WS_BIG + 400 * MiB;
constexpr size_t WS_HS = WS_BIG + BIG_BYTES;
constexpr size_t WS_END = WS_HS + (size_t)SLOTS_MAX * D * 2;
static_assert(WS_ACT + (size_t)T * FF * 2 <= WS_BIG + BIG_BYTES && WS_Y + (size_t)T * D * 2 <= WS_BIG + BIG_BYTES, "overlays fit");
static_assert(WS_WQKV % 256 == 0 && WS_H % 256 == 0 && WS_BIG % 256 == 0 && WS_HS % 256 == 0, "alignment");

constexpr int TAIL_PM0 = 128;
__host__ __device__ __forceinline__ int tail_split(int R) { return R <= 2 ? 14 : (R <= 4 ? 7 : 4); }
constexpr int CW_TMO = 0;
constexpr int CW_BAR = 4096;

constexpr int RING_OFF = 0, RING_BYTES = 131072;
constexpr int LTAB_OFF = 135168;
constexpr int MISC_OFF = LTAB_OFF + 1024;
constexpr int LDS_BYTES = 147456;

#define RLX_AGENT __ATOMIC_RELAXED, __HIP_MEMORY_SCOPE_AGENT
#define LDS_WAIT() asm volatile("s_waitcnt lgkmcnt(0)" ::: "memory")
#define VM_WAIT() asm volatile("s_waitcnt vmcnt(0)" ::: "memory")

#define XB_TMO      128
#define XB_XCNT(j)  (256  + 64 * (j))
#define XB_XSUB(j)  (1280 + 64 * (j))
#define XB_XGEN(j)  (2304 + 64 * (j))
#define XB_TOP      3328
#define XB_TOPGEN   3392
#define XCD_BAR_WORDS 3456
#define XB_SPIN_CAP (1u << 18)
__device__ __forceinline__ unsigned xb_ld(unsigned* p)              { return __hip_atomic_load(p, __ATOMIC_RELAXED, __HIP_MEMORY_SCOPE_AGENT); }
__device__ __forceinline__ unsigned xb_add(unsigned* p, unsigned v) { return __hip_atomic_fetch_add(p, v, __ATOMIC_RELAXED, __HIP_MEMORY_SCOPE_AGENT); }
__device__ __forceinline__ unsigned xb_xcc_id() { return (unsigned)__builtin_amdgcn_s_getreg((3 << 11) | 20) & 0xFu; }
#define XB_SPIN(cond, bar) do { unsigned _sp = 0; while (cond) { __builtin_amdgcn_s_sleep(1); \
    if ((++_sp & 255u) == 0u) { if (xb_ld(&(bar)[XB_TMO])) break; if (_sp > XB_SPIN_CAP) { atomicAdd(&(bar)[XB_TMO], 1u); break; } } } } while (0)
struct XcdBarrier { unsigned* bar; unsigned x; volatile LAS unsigned* st; };
__device__ __forceinline__ XcdBarrier xcd_barrier_post(unsigned* bar, volatile LAS unsigned* st) {
    XcdBarrier b; b.bar = bar; b.x = xb_xcc_id(); b.st = st;
    if (threadIdx.x == 0) (void)xb_add(&bar[XB_XCNT(b.x)], 1u);
    return b;
}
__device__ __forceinline__ void xcd_barrier_complete(unsigned* bar, unsigned x, unsigned& nloc, unsigned& nx) {
    const unsigned G = gridDim.x * gridDim.y * gridDim.z;
    unsigned sum, cnt, mine, sp = 0u;
    for (;;) {
        sum = 0u; cnt = 0u; mine = 0u;
#pragma unroll
        for (unsigned j = 0; j < 16; ++j) { const unsigned c = xb_ld(&bar[XB_XCNT(j)]); sum += c; cnt += (c > 0u) ? 1u : 0u; mine = (j == x) ? c : mine; }
        if (sum == G) break;
        __builtin_amdgcn_s_sleep(1);
        if ((++sp & 255u) == 0u) { if (xb_ld(&bar[XB_TMO])) break; if (sp > XB_SPIN_CAP) { atomicAdd(&bar[XB_TMO], 1u); break; } }
    }
    nloc = mine > 0u ? mine : 1u; nx = cnt > 0u ? cnt : 1u;
}
__device__ __forceinline__ void xcd_barrier(const XcdBarrier& b) {
    asm volatile("s_waitcnt vmcnt(0)" ::: "memory");
    __syncthreads();
    if (threadIdx.x == 0) {
        unsigned* bar = b.bar;
        __builtin_amdgcn_s_waitcnt(0);
        unsigned nloc = b.st[0], nx = b.st[1];
        if (nloc == 0u) { xcd_barrier_complete(bar, b.x, nloc, nx); b.st[0] = nloc; b.st[1] = nx; }
        const unsigned old = xb_add(&bar[XB_XSUB(b.x)], 1u);
        const unsigned gen = old / nloc;
        if (old + 1u == (gen + 1u) * nloc) {
            __builtin_amdgcn_fence(__ATOMIC_RELEASE, "agent");
            asm volatile("s_waitcnt vmcnt(0)" ::: "memory");
            const unsigned og = xb_add(&bar[XB_TOP], 1u);
            const unsigned tg = og / nx;
            if (og + 1u == (tg + 1u) * nx) xb_add(&bar[XB_TOPGEN], 1u);
            else XB_SPIN(xb_ld(&bar[XB_TOPGEN]) == tg, bar);
            __builtin_amdgcn_fence(__ATOMIC_ACQUIRE, "agent");
            xb_add(&bar[XB_XGEN(b.x)], 1u);
            asm volatile("s_waitcnt vmcnt(0)" ::: "memory");
        } else {
            XB_SPIN(xb_ld(&bar[XB_XGEN(b.x)]) == gen, bar);
            __builtin_amdgcn_fence(__ATOMIC_ACQUIRE, "agent");
            asm volatile("s_waitcnt vmcnt(0)" ::: "memory");
        }
    }
    __syncthreads();
}

__device__ __forceinline__ float wave_sum(float v) {
#pragma unroll
    for (int o = 1; o < 64; o <<= 1) v += __shfl_xor(v, o);
    return v;
}
__device__ __forceinline__ int wave_sum_i(int v) {
#pragma unroll
    for (int o = 1; o < 64; o <<= 1) v += __shfl_xor(v, o);
    return v;
}

struct CvtDesc { const float* src; unsigned char* dst; int N; int ldd; int f8; int nkt, perm, drow0, kb0; unsigned* cmax; };
__device__ __forceinline__ void cvt_mk(CvtDesc& d, const float* W, int N, void* WT, int ldd_elems, int map, int f8, int item, int nkt = 0, int perm = 0, unsigned* cmax = nullptr) {
    const int nblk = N >> 6, kb = item / nblk, nb = item - kb * nblk, k0 = kb << 6, n0 = nb << 6;
    const int drow0 = (map == 0) ? n0 : (((n0 >> 7) << 8) + (n0 & 127) + (map == 2 ? 128 : 0)), esz = f8 ? 1 : 2;
    d.src = W + (size_t)k0 * N + n0; d.N = N; d.ldd = ldd_elems * esz; d.f8 = f8; d.nkt = nkt; d.perm = perm; d.drow0 = drow0; d.kb0 = k0 * esz; d.cmax = cmax;
    d.dst = nkt ? (unsigned char*)WT : (unsigned char*)WT + ((size_t)drow0 * ldd_elems + k0) * esz;
}
__device__ __forceinline__ unsigned char* cvt_dst(const CvtDesc& d, int n, int cbyte) {
    if (!d.nkt) return d.dst + (size_t)n * d.ldd + cbyte;
    int row = d.drow0 + n; if (d.perm) row = (row & ~31) + inv_perm32(row & 31);
    return d.dst + tiled_off(row, d.kb0 + cbyte, d.nkt);
}
__device__ __forceinline__ void cvt_load(const CvtDesc& d, f32x4 (&v)[16], int lane) {
    const float* src = d.src + (size_t)(lane >> 4) * d.N + 4 * (lane & 15);
#pragma unroll
    for (int i = 0; i < 16; ++i) v[i] = __builtin_nontemporal_load((const f32x4*)(src + (size_t)(4 * i) * d.N));
}
__device__ __forceinline__ void cvt_process(const CvtDesc& d, const f32x4 (&v)[16], LAS float* scr, int lane) {
    { const int r4 = lane >> 4, c4 = lane & 15;
#pragma unroll
      for (int i = 0; i < 16; ++i) { LAS float* p = scr + (4 * i + r4) * 65 + 4 * c4; p[0] = v[i].x; p[1] = v[i].y; p[2] = v[i].z; p[3] = v[i].w; } }
    LDS_WAIT(); asm volatile("" ::: "memory");
    const int c = lane & 7;
    if (d.f8) {
#pragma unroll
        for (int j = 0; j < 8; ++j) { const int n = (lane >> 3) + 8 * j; const LAS float* s = scr + (8 * c) * 65 + n;
            u32x2 o; o.x = pk4_fp8(s[0 * 65] * W8_SCALE, s[1 * 65] * W8_SCALE, s[2 * 65] * W8_SCALE, s[3 * 65] * W8_SCALE); o.y = pk4_fp8(s[4 * 65] * W8_SCALE, s[5 * 65] * W8_SCALE, s[6 * 65] * W8_SCALE, s[7 * 65] * W8_SCALE);
            *(u32x2*)cvt_dst(d, n, 8 * c) = o; }
    } else {
#pragma unroll
        for (int j = 0; j < 8; ++j) { const int n = (lane >> 3) + 8 * j; const LAS float* s = scr + (8 * c) * 65 + n;
            u32x4 o; o.x = pk2(s[0 * 65], s[1 * 65]); o.y = pk2(s[2 * 65], s[3 * 65]); o.z = pk2(s[4 * 65], s[5 * 65]); o.w = pk2(s[6 * 65], s[7 * 65]);
            *(u32x4*)cvt_dst(d, n, 16 * c) = o;
            if (d.cmax) {
                float mx = fmaxf(fmaxf(fmaxf(fabsf(s[0 * 65]), fabsf(s[1 * 65])), fmaxf(fabsf(s[2 * 65]), fabsf(s[3 * 65]))), fmaxf(fmaxf(fabsf(s[4 * 65]), fabsf(s[5 * 65])), fmaxf(fabsf(s[6 * 65]), fabsf(s[7 * 65]))));
                mx = fmaxf(mx, __shfl_xor(mx, 1)); mx = fmaxf(mx, __shfl_xor(mx, 2)); mx = fmaxf(mx, __shfl_xor(mx, 4));
                if (c == 0) atomicMax(d.cmax + d.drow0 + n, __float_as_uint(mx)); } }
    }
    LDS_WAIT(); asm volatile("" ::: "memory");
}


struct MoeCvtTile { const float* src; unsigned char* dst; int N; int kind; int n0; int k0; };
__device__ __forceinline__ void moe_cvt_decode(MoeCvtTile& t, int tile, const float* wg, const float* wu, const float* wd, unsigned char* Wmgu8, unsigned char* Wmd8) {
    constexpr int TPE = 448;
    const int mat = tile / (NE * TPE), r = tile - mat * (NE * TPE), e = r / TPE, q = r - e * TPE;
    if (mat < 2) { const int kb = q / 14, nb = q - kb * 14; t.src = (mat == 0 ? wg : wu) + (size_t)e * D * FFE + (size_t)(kb * 64) * FFE + nb * 512; t.N = FFE; t.kind = mat; t.n0 = nb * 512; t.k0 = kb * 64; t.dst = Wmgu8 + (size_t)e * 2 * FFE * D; }
    else { const int kb = q >> 2, nb = q & 3; t.src = wd + (size_t)e * FFE * D + (size_t)(kb * 64) * D + nb * 512; t.N = D; t.kind = 2; t.n0 = nb * 512; t.k0 = kb * 64; t.dst = Wmd8 + (size_t)e * D * FFE; }
}
__device__ __forceinline__ void moe_cvt_load(const MoeCvtTile& t, f32x4 (&v)[16], int tid) {
    const float* p = t.src + (size_t)(tid >> 7) * t.N + 4 * (tid & 127);
#pragma unroll
    for (int i = 0; i < 16; ++i) v[i] = __builtin_nontemporal_load((const f32x4*)(p + (size_t)(4 * i) * t.N));
}
__device__ __forceinline__ void moe_cvt_process(const MoeCvtTile& t, const f32x4 (&v)[16], LAS float* scr, int tid) {
    { LAS f32x4* w = (LAS f32x4*)(scr + (tid >> 7) * 512 + 4 * (tid & 127));
#pragma unroll
      for (int i = 0; i < 16; ++i) w[i * 512] = v[i]; }
    __syncthreads();
    const int n = t.n0 + tid;
    u32x4 o[4];
#pragma unroll
    for (int j = 0; j < 4; ++j) { const LAS float* s = scr + (16 * j) * 512 + tid;
        o[j].x = pk4_fp8(s[0 * 512] * W8_SCALE, s[1 * 512] * W8_SCALE, s[2 * 512] * W8_SCALE, s[3 * 512] * W8_SCALE); o[j].y = pk4_fp8(s[4 * 512] * W8_SCALE, s[5 * 512] * W8_SCALE, s[6 * 512] * W8_SCALE, s[7 * 512] * W8_SCALE);
        o[j].z = pk4_fp8(s[8 * 512] * W8_SCALE, s[9 * 512] * W8_SCALE, s[10 * 512] * W8_SCALE, s[11 * 512] * W8_SCALE); o[j].w = pk4_fp8(s[12 * 512] * W8_SCALE, s[13 * 512] * W8_SCALE, s[14 * 512] * W8_SCALE, s[15 * 512] * W8_SCALE); }
    if (t.kind < 2) { unsigned char* d = t.dst + (size_t)(((n >> 7) << 8) + (n & 127) + (t.kind == 1 ? 128 : 0)) * D + t.k0;
#pragma unroll
        for (int j = 0; j < 4; ++j) *(u32x4*)(d + 16 * j) = o[j]; }
    else { const int row = (n & ~31) + inv_perm32(n & 31);
#pragma unroll
        for (int j = 0; j < 4; ++j) *(u32x4*)(t.dst + tiled_off(row, t.k0 + 16 * j, FFE / 128)) = o[j]; }
    __syncthreads();
}

__device__ __forceinline__ void rms_load(f32x4 (&v)[8], const float* X, int m, int lane) { const f32x4* xr = (const f32x4*)(X + (size_t)m * D) + lane;
#pragma unroll
    for (int j = 0; j < 8; ++j) v[j] = xr[64 * j]; }
__device__ __forceinline__ float wave_max(float v) {
#pragma unroll
    for (int o = 1; o < 64; o <<= 1) v = fmaxf(v, __shfl_xor(v, o));
    return v;
}
__device__ __forceinline__ unsigned pk4_i8(float a, float b, float c, float d) {
    a = __builtin_amdgcn_fmed3f(a, -127.f, 127.f); b = __builtin_amdgcn_fmed3f(b, -127.f, 127.f); c = __builtin_amdgcn_fmed3f(c, -127.f, 127.f); d = __builtin_amdgcn_fmed3f(d, -127.f, 127.f);
    const unsigned ua = (unsigned)(int)(a + 128.f), ub = (unsigned)(int)(b + 128.f), uc = (unsigned)(int)(c + 128.f), ud = (unsigned)(int)(d + 128.f);
    return (ua | (ub << 8) | (uc << 16) | (ud << 24)) ^ 0x80808080u; }
__device__ __forceinline__ void rms_finish_i8(const f32x4 (&v)[8], const f32x4 (&g)[8], bf16_t* H, float* sA, int m, int lane) {
    float s = 0.f;
#pragma unroll
    for (int j = 0; j < 8; ++j) s += (v[j].x * v[j].x + v[j].y * v[j].y) + (v[j].z * v[j].z + v[j].w * v[j].w);
    const float rs = 1.0f / sqrtf(wave_sum(s) * (1.f / D) + EPS);
    f32x4 h[8]; float am = 0.f;
#pragma unroll
    for (int j = 0; j < 8; ++j) { h[j] = v[j] * rs * g[j]; am = fmaxf(am, fmaxf(fmaxf(fabsf(h[j].x), fabsf(h[j].y)), fmaxf(fabsf(h[j].z), fabsf(h[j].w)))); }
    am = fmaxf(wave_max(am), 1e-30f);
    const float inv = 127.0f / am;
    unsigned* o4 = (unsigned*)((unsigned char*)H + (size_t)m * D) + lane;
#pragma unroll
    for (int j = 0; j < 8; ++j) o4[64 * j] = pk4_i8(__builtin_rintf(h[j].x * inv), __builtin_rintf(h[j].y * inv), __builtin_rintf(h[j].z * inv), __builtin_rintf(h[j].w * inv));
    if (lane == 0) sA[m] = am * (1.0f / 127.0f);
}
__device__ __forceinline__ void rms_finish(const f32x4 (&v)[8], const f32x4 (&g)[8], bf16_t* H, int m, int lane) {
    float s = 0.f;
#pragma unroll
    for (int j = 0; j < 8; ++j) s += (v[j].x * v[j].x + v[j].y * v[j].y) + (v[j].z * v[j].z + v[j].w * v[j].w);
    const float rs = 1.0f / sqrtf(wave_sum(s) * (1.f / D) + EPS);
    u32x2* o8 = (u32x2*)(H + (size_t)m * D) + lane;
#pragma unroll
    for (int j = 0; j < 8; ++j) { u32x2 w; w.x = pk2(v[j].x * rs * g[j].x, v[j].y * rs * g[j].y); w.y = pk2(v[j].z * rs * g[j].z, v[j].w * rs * g[j].w); o8[64 * j] = w; }
}
template <bool I8 = false> __device__ __forceinline__ void rms_phase(const float* X, const float* gain, bf16_t* H, int gw, int NGW, int lane, float* sA = nullptr) {
    f32x4 g[8], va[8], vb[8];
#pragma unroll
    for (int j = 0; j < 8; ++j) g[j] = ((const f32x4*)gain + lane)[64 * j];
    int m = gw; if (m >= T) return;
    rms_load(va, X, m, lane);
    for (;;) {
        const int mn = m + NGW; if (mn < T) rms_load(vb, X, mn, lane);
        if constexpr (I8) rms_finish_i8(va, g, H, sA, m, lane); else rms_finish(va, g, H, m, lane);
        if (mn >= T) break;
        m = mn + NGW; if (m < T) rms_load(va, X, m, lane);
        if constexpr (I8) rms_finish_i8(vb, g, H, sA, mn, lane); else rms_finish(vb, g, H, mn, lane);
        if (m >= T) break;
    }
}

__device__ __forceinline__ unsigned off_b(unsigned row, unsigned ch) { return 256u * row + 16u * (ch ^ (((row & 3u) << 2) | ((row >> 2) & 3u))); }
__device__ __forceinline__ s16x4 tr_read(const LAS unsigned char* p) { return __builtin_bit_cast(s16x4, __builtin_amdgcn_ds_read_tr16_b64_v4i16((LAS s16x4*)p)); }

__device__ __forceinline__ void quant_rows_i8(const bf16_t* W, unsigned char* W8, const unsigned* cmax, float* sw, int rows, int gw, int NGW, int lane) {
    for (int n = gw; n < rows; n += NGW) {
        const float am = fmaxf(__uint_as_float(cmax[n]), 1e-30f), inv = 127.0f / am;
        const u32x4* src = (const u32x4*)(W + (size_t)n * D); u32x4* dst = (u32x4*)(W8 + (size_t)n * D) + lane;
        u32x4 wv[4];
#pragma unroll
        for (int k = 0; k < 4; ++k) wv[k] = src[2 * lane + (k & 1) + 128 * (k >> 1)];
#pragma unroll
        for (int k = 0; k < 4; k += 2) { u32x4 o; const u32x4 a = wv[k], b2 = wv[k + 1];
            o.x = pk4_i8(__builtin_rintf(bf_lo(a.x) * inv), __builtin_rintf(bf_hi(a.x) * inv), __builtin_rintf(bf_lo(a.y) * inv), __builtin_rintf(bf_hi(a.y) * inv));
            o.y = pk4_i8(__builtin_rintf(bf_lo(a.z) * inv), __builtin_rintf(bf_hi(a.z) * inv), __builtin_rintf(bf_lo(a.w) * inv), __builtin_rintf(bf_hi(a.w) * inv));
            o.z = pk4_i8(__builtin_rintf(bf_lo(b2.x) * inv), __builtin_rintf(bf_hi(b2.x) * inv), __builtin_rintf(bf_lo(b2.y) * inv), __builtin_rintf(bf_hi(b2.y) * inv));
            o.w = pk4_i8(__builtin_rintf(bf_lo(b2.z) * inv), __builtin_rintf(bf_hi(b2.z) * inv), __builtin_rintf(bf_lo(b2.w) * inv), __builtin_rintf(bf_hi(b2.w) * inv));
            dst[64 * (k >> 1)] = o; }
        if (lane == 0) sw[n] = am * (1.0f / 127.0f);
    }
}

struct Args { const float* in[21]; float* out; unsigned char* ws; int ph_lo, ph_hi; };

enum { I_X = 0, I_MIXN, I_FFNN, I_RELB, I_WQKV, I_QG, I_KG, I_SINK, I_WO, I_FG, I_FU, I_FD, I_PIN, I_PG, I_PSC, I_POUT, I_RW, I_RB, I_MG, I_MU, I_MD };

__global__ void __launch_bounds__(NWAVES * 64, 2) fwd_kernel(Args args) {
    extern __shared__ __attribute__((aligned(16))) unsigned char lds_raw[];
    LAS unsigned char* lds = (LAS unsigned char*)lds_raw;
    volatile LAS unsigned* MISC = (volatile LAS unsigned*)(lds + MISC_OFF);
    const int tid = threadIdx.x, lane = tid & 63, wave = __builtin_amdgcn_readfirstlane(tid >> 6);
    const int G = gridDim.x, bx = blockIdx.x;
    const int gw = bx * NWAVES + wave, NGW = G * NWAVES;
    unsigned char* ws = args.ws;
    gu32* ctl = (gu32*)(ws + WS_CTL);
    if (tid < 32) MISC[tid] = 0u;
    __syncthreads();
    XcdBarrier bar; bar.bar = (unsigned*)(ws + WS_CTL) + CW_BAR; bar.x = 0; bar.st = nullptr;
    if (N_LAUNCHES == 1) bar = xcd_barrier_post((unsigned*)(ws + WS_CTL) + CW_BAR, MISC + 8);
#define GRID_BAR() do { if (N_LAUNCHES == 1) xcd_barrier(bar); } while (0)
    const int lo = args.ph_lo, hi = args.ph_hi;
#define IN(k) (lo <= (k) && (k) < hi)
#define REP(k) for (int _rep = 0; _rep < (((PROBE_MASK >> (k)) & 1) ? 2 : 1); ++_rep)
#define BOTH(k) (IN(k) && IN((k) + 1))

    bf16_t* const Wqkv = (bf16_t*)(ws + WS_WQKV); bf16_t* const Wo = (bf16_t*)(ws + WS_WO); bf16_t* const Wgu = (bf16_t*)(ws + WS_WGU); bf16_t* const Wd = (bf16_t*)(ws + WS_WD);
    bf16_t* const Win = (bf16_t*)(ws + WS_WIN); bf16_t* const Wg = (bf16_t*)(ws + WS_WG); bf16_t* const Wout = (bf16_t*)(ws + WS_WOUT);
    bf16_t* const Wmgu = (bf16_t*)(ws + WS_WMGU); bf16_t* const Wmd = (bf16_t*)(ws + WS_WMD);
    bf16_t* const Hb = (bf16_t*)(ws + WS_H); bf16_t* const QKV = (bf16_t*)(ws + WS_QKV); bf16_t* const AO = (bf16_t*)(ws + WS_AO); bf16_t* const ACT = (bf16_t*)(ws + WS_ACT);
    bf16_t* const Ub = (bf16_t*)(ws + WS_U); bf16_t* const DDb = (bf16_t*)(ws + WS_DD); bf16_t* const Yb = (bf16_t*)(ws + WS_Y);
    bf16_t* const ACTM = (bf16_t*)(ws + WS_ACTM); bf16_t* const HS = (bf16_t*)(ws + WS_HS);
    int* const tab_te = (int*)(ws + WS_TAB + TAB_TE); float* const tab_tw = (float*)(ws + WS_TAB + TAB_TW); int* const tab_cnt = (int*)(ws + WS_TAB + TAB_CNT);
    int* const tab_slot = (int*)(ws + WS_TAB + TAB_SLOT); float* const tab_wslot = (float*)(ws + WS_TAB + TAB_WSLOT); int* const tab_tile = (int*)(ws + WS_TAB + TAB_TILE);
    float* const OUT = args.out;
    unsigned* const cmax_gu = (unsigned*)(ws + WS_CTL + CTL_CMAX); float* const tab_sa = (float*)(ws + WS_TAB + TAB_SA); float* const tab_sw = (float*)(ws + WS_TAB + TAB_SW);
    unsigned char* const Wgu8 = ws + WS_WGU8; unsigned char* const Wqkv8 = ws + WS_WGU8 + (size_t)2 * FF * D; unsigned char* const Win8 = Wqkv8 + (size_t)QKVD * D; bf16_t* const Wpt = (bf16_t*)(Win8 + (size_t)D * D);

        LAS float* scr = (LAS float*)(lds + RING_OFF + wave * 16640);
        constexpr int I_1 = (D / 64) * (QKVD / 64), I_2 = (D / 64) * (D / 64), I_3 = (D / 64) * (FF / 64), I_7 = 0, I_M = (D / 64) * (FFE / 64);
        constexpr int E1 = I_1, E2 = E1 + I_2, E3 = E2 + I_3, E4 = E3 + I_3, E5 = E4 + I_3, E6 = E5 + I_2, E7 = E6 + I_7, E8 = E7 + I_2, E9 = E8 + NE * I_M, E10 = E9 + NE * I_M, E11 = E10 + NE * I_M;
#define CVT_DECODE(it_, d_) do { const int _it = (it_); \
            if (_it < E1) cvt_mk(d_, args.in[I_WQKV], QKVD, Wqkv, D, 0, 0, _it, 0, 0, cmax_gu + 2 * FF); \
            else if (_it < E2) cvt_mk(d_, args.in[I_WO], D, Wo, D, 0, 1, _it - E1); \
            else if (_it < E3) cvt_mk(d_, args.in[I_FG], FF, Wgu, D, 1, 0, _it - E2, 0, 0, cmax_gu); \
            else if (_it < E4) cvt_mk(d_, args.in[I_FU], FF, Wgu, D, 2, 0, _it - E3, 0, 0, cmax_gu); \
            else if (_it < E5) cvt_mk(d_, args.in[I_FD], D, Wd, FF, 0, 1, _it - E4, FF / 128, 0); \
            else if (_it < E6) cvt_mk(d_, args.in[I_PIN], D, Win, D, 0, 0, _it - E5, 0, 0, cmax_gu + 2 * FF + QKVD); \
            else if (_it < E7) { const int _r = _it - E6, _g = _r >> 6; cvt_mk(d_, args.in[I_PG] + (size_t)_g * 512 * 512, 512, Wg + (size_t)_g * 512 * 512, 512, 0, 0, _r & 63); } \
            else if (_it < E8) cvt_mk(d_, args.in[I_POUT], D, Wout, D, 0, 0, _it - E7); \
            else if (_it < E9) { const int _r = _it - E8, _e = _r / I_M; cvt_mk(d_, args.in[I_MG] + (size_t)_e * D * FFE, FFE, (unsigned char*)Wmgu + (size_t)_e * 2 * FFE * D, D, 1, 1, _r - _e * I_M); } \
            else if (_it < E10) { const int _r = _it - E9, _e = _r / I_M; cvt_mk(d_, args.in[I_MU] + (size_t)_e * D * FFE, FFE, (unsigned char*)Wmgu + (size_t)_e * 2 * FFE * D, D, 2, 1, _r - _e * I_M); } \
            else { const int _r = _it - E10, _e = _r / I_M; cvt_mk(d_, args.in[I_MD] + (size_t)_e * FFE * D, D, (unsigned char*)Wmd + (size_t)_e * D * FFE, FFE, 0, 1, _r - _e * I_M, FFE / 128, 1); } } while (0)
#define CVT_RUN(IT0, IT1) do { CvtDesc dA, dB; f32x4 vA[16], vB[16]; int it = (IT0) + gw; \
          if (it < (IT1)) { CVT_DECODE(it, dA); cvt_load(dA, vA, lane); } \
          while (it < (IT1)) { \
              int itn = it + NGW; \
              if (itn < (IT1)) { CVT_DECODE(itn, dB); cvt_load(dB, vB, lane); } \
              cvt_process(dA, vA, scr, lane); \
              it = itn; if (it >= (IT1)) break; \
              itn = it + NGW; \
              if (itn < (IT1)) { CVT_DECODE(itn, dA); cvt_load(dA, vA, lane); } \
              cvt_process(dB, vB, scr, lane); \
              it = itn; \
          } } while (0)
    if (IN(0)) { REP(0) {
        CVT_RUN(0, E8);
        for (int i8 = bx * (NWAVES * 64) + tid; i8 < 4 * 512 * 512 / 8; i8 += G * NWAVES * 64) {
            const int e0 = (i8 & 63) * 8, g_ = i8 >> 15; const float* wp = args.in[I_PG] + (size_t)i8 * 8; const float* sp = args.in[I_PSC] + g_ * 512 + e0;
            const f32x4 a = *(const f32x4*)wp, b2 = *(const f32x4*)(wp + 4), sa_ = *(const f32x4*)sp, sb_ = *(const f32x4*)(sp + 4);
            u32x4 o; o.x = pk2(a.x * sa_.x, a.y * sa_.y); o.y = pk2(a.z * sa_.z, a.w * sa_.w); o.z = pk2(b2.x * sb_.x, b2.y * sb_.y); o.w = pk2(b2.z * sb_.z, b2.w * sb_.w);
            *(u32x4*)(Wg + (size_t)i8 * 8) = o; }
        }
        if (BOTH(0)) GRID_BAR();
    }
    if (IN(1)) { REP(1) {
        { pg8::WprodSched S; S.init(Wout, Wg, G, bx);
          pg8::EpiBf16 E{Wpt, D, nullptr};
          pg8::gemm_phase<pg8::EpiBf16, pg8::WprodSched>(lds + RING_OFF, pg8::Gemm{D, 512, 512 / 64}, S, E); }
        { LAS float* scrb = (LAS float*)(lds + RING_OFF); MoeCvtTile tA, tB; f32x4 vA[16], vB[16];
          constexpr int NTILES = 3 * NE * 448; int it = bx;
          if (it < NTILES) { moe_cvt_decode(tA, it, args.in[I_MG], args.in[I_MU], args.in[I_MD], (unsigned char*)Wmgu, (unsigned char*)Wmd); moe_cvt_load(tA, vA, tid); }
          while (it < NTILES) {
              int itn = it + G;
              if (itn < NTILES) { moe_cvt_decode(tB, itn, args.in[I_MG], args.in[I_MU], args.in[I_MD], (unsigned char*)Wmgu, (unsigned char*)Wmd); moe_cvt_load(tB, vB, tid); }
              moe_cvt_process(tA, vA, scrb, tid);
              it = itn; if (it >= NTILES) break;
              itn = it + G;
              if (itn < NTILES) { moe_cvt_decode(tA, itn, args.in[I_MG], args.in[I_MU], args.in[I_MD], (unsigned char*)Wmgu, (unsigned char*)Wmd); moe_cvt_load(tA, vA, tid); }
              moe_cvt_process(tB, vB, scrb, tid);
              it = itn;
          } }
        quant_rows_i8(Wgu, Wgu8, cmax_gu, tab_sw, 2 * FF, gw, NGW, lane);
        quant_rows_i8(Wqkv, Wqkv8, cmax_gu + 2 * FF, tab_sw + 2 * FF, QKVD, gw, NGW, lane);
        quant_rows_i8(Win, Win8, cmax_gu + 2 * FF + QKVD, tab_sw + 2 * FF + QKVD, D, gw, NGW, lane);
        if (G > 64) { if (bx >= 64) rms_phase<true>(args.in[I_X], args.in[I_MIXN], Hb, (bx - 64) * NWAVES + wave, (G - 64) * NWAVES, lane, tab_sa); }
        else rms_phase<true>(args.in[I_X], args.in[I_MIXN], Hb, gw, NGW, lane, tab_sa);
        }
        if (BOTH(1)) GRID_BAR();
    }
#undef CVT_RUN
#undef CVT_DECODE

    if (IN(2)) { REP(2) {
        pg8::DenseSched S; S.init(Hb, (const bf16_t*)Wqkv8, T, QKVD, D / 2, D / 2, G, bx);
        pg8::EpiBf16i8 E{QKV, QKVD, tab_sa, tab_sw + 2 * FF};
        pg8::gemm_phase<pg8::EpiBf16i8, pg8::DenseSched, 2>(lds + RING_OFF, pg8::Gemm{D / 2, D / 2, D / 128}, S, E);
        }
        if (BOTH(2)) GRID_BAR();
    }


    if (IN(4)) { REP(4) {
        LAS float* tab = (LAS float*)(lds + 65536);
        for (int i = tid; i < 16 * 384; i += NWAVES * 64) {
            const int h = i / 384, r = (i - h * 384) - 192; float v = 0.f;
            if (r >= -128 && r <= 128) { const int n = r < 0 ? -r : r; int large = 2 + (31 - __builtin_clz((unsigned)(n * n) | 1u)); large = large < 15 ? large : 15;
                const int bucket = (r > 0 ? 16 : 0) + (n < 8 ? n : large); v = args.in[I_RELB][bucket * NH + h] * LOG2E; }
            tab[i] = v;
        }
        __syncthreads();
        const int g = wave >> 1, qh = wave & 1, r = lane & 31, h = lane >> 5;
        const f32x4 kg0 = *(const f32x4*)(args.in[I_KG] + (tid & 15) * 8), kg1 = *(const f32x4*)(args.in[I_KG] + (tid & 15) * 8 + 4);
        const float qsc = 0.08838834764831845f * LOG2E;
        const unsigned xr = ((r & 3u) << 2) | ((r >> 2) & 3u);
        const int tq = (lane & 15) >> 2, tp = lane & 3, tblk = (lane >> 4) & 1;
        for (int it = bx; it < BATCH * NKV * (SEQ / 64); it += G) {
            const int b = it >> 9, kvh = (it >> 7) & 3, qb = it & 127;
            const int q0 = qb * 64, ks0 = q0 - 128;
            const int c_lo = ks0 < 0 ? ((-ks0) >> 6) : 0;
            int c_hi = (SEQ - 1 - ks0) >> 6; c_hi = c_hi > 4 ? 4 : c_hi;
            const int hq = kvh * 4 + g;
            const size_t tokbase = (size_t)b * SEQ;
            const int qpos = q0 + 32 * qh + r;
            u32x4 kr[2], vr[2];
#define ATT_LOAD(c) do { _Pragma("unroll") for (int _i = 0; _i < 2; ++_i) { const int _p = tid + 512 * _i, _key = _p >> 4, _ch = _p & 15; \
                const bf16_t* _kp = QKV + (tokbase + (ks0 + 64 * (c) + _key)) * QKVD + D + kvh * HD + _ch * 8; kr[_i] = *(const u32x4*)_kp; vr[_i] = *(const u32x4*)(_kp + NKV * HD); } } while (0)
#define ATT_STORE(buf) do { _Pragma("unroll") for (int _i = 0; _i < 2; ++_i) { const int _p = tid + 512 * _i, _key = _p >> 4, _ch = _p & 15; \
                const unsigned _o = (unsigned)(buf) * 32768u + (unsigned)(_key >> 5) * 8192u + off_b((unsigned)(_key & 31), (unsigned)_ch); \
                const u32x4 _w = kr[_i]; float _ss = (bf_lo(_w.x) * bf_lo(_w.x) + bf_hi(_w.x) * bf_hi(_w.x)) + (bf_lo(_w.y) * bf_lo(_w.y) + bf_hi(_w.y) * bf_hi(_w.y)) + (bf_lo(_w.z) * bf_lo(_w.z) + bf_hi(_w.z) * bf_hi(_w.z)) + (bf_lo(_w.w) * bf_lo(_w.w) + bf_hi(_w.w) * bf_hi(_w.w)); \
                _ss += __shfl_xor(_ss, 1); _ss += __shfl_xor(_ss, 2); _ss += __shfl_xor(_ss, 4); _ss += __shfl_xor(_ss, 8);            \
                const float _rs = 1.0f / sqrtf(_ss * (1.f / HD) + EPS); const f32x4 _g0 = kg0 * _rs, _g1 = kg1 * _rs; \
                u32x4 _kn; _kn.x = pk2(bf_lo(_w.x) * _g0.x, bf_hi(_w.x) * _g0.y); _kn.y = pk2(bf_lo(_w.y) * _g0.z, bf_hi(_w.y) * _g0.w); _kn.z = pk2(bf_lo(_w.z) * _g1.x, bf_hi(_w.z) * _g1.y); _kn.w = pk2(bf_lo(_w.w) * _g1.z, bf_hi(_w.w) * _g1.w); \
                *(LAS u32x4*)(lds + _o) = _kn; *(LAS u32x4*)(lds + 16384u + _o) = vr[_i]; } } while (0)
            ATT_LOAD(c_lo);
            bf16x8 qf[8];
            { const bf16_t* qp = QKV + (tokbase + qpos) * QKVD + hq * HD + 8 * h;
#pragma unroll
              for (int s = 0; s < 8; ++s) qf[s] = *(const bf16x8*)(qp + 16 * s);
              float ss = 0.f;
#pragma unroll
              for (int s = 0; s < 8; ++s) { const u32x4 w = __builtin_bit_cast(u32x4, qf[s]);
                  ss += (bf_lo(w.x) * bf_lo(w.x) + bf_hi(w.x) * bf_hi(w.x)) + (bf_lo(w.y) * bf_lo(w.y) + bf_hi(w.y) * bf_hi(w.y)) + (bf_lo(w.z) * bf_lo(w.z) + bf_hi(w.z) * bf_hi(w.z)) + (bf_lo(w.w) * bf_lo(w.w) + bf_hi(w.w) * bf_hi(w.w)); }
              ss += __shfl_xor(ss, 32);
              const float rsq = qsc / sqrtf(ss * (1.f / HD) + EPS);
              const float* qgp = args.in[I_QG] + 8 * h;
#pragma unroll
              for (int s = 0; s < 8; ++s) { const u32x4 w = __builtin_bit_cast(u32x4, qf[s]); const f32x4 ga = *(const f32x4*)(qgp + 16 * s) * rsq, gb = *(const f32x4*)(qgp + 16 * s + 4) * rsq;
                  u32x4 o; o.x = pk2(bf_lo(w.x) * ga.x, bf_hi(w.x) * ga.y); o.y = pk2(bf_lo(w.y) * ga.z, bf_hi(w.y) * ga.w); o.z = pk2(bf_lo(w.z) * gb.x, bf_hi(w.z) * gb.y); o.w = pk2(bf_lo(w.w) * gb.z, bf_hi(w.w) * gb.w);
                  qf[s] = __builtin_bit_cast(bf16x8, o); } }
            f32x16 O[4];
#pragma unroll
            for (int c = 0; c < 4; ++c)
#pragma unroll
                for (int i = 0; i < 16; ++i) O[c][i] = 0.f;
            float m_run = args.in[I_SINK][hq] * LOG2E, l_run = (h == 0) ? 1.0f : 0.0f;
            ATT_STORE(0);
            __syncthreads();
            for (int c = c_lo; c <= c_hi; ++c) {
                const int cur = (c - c_lo) & 1;
                if (c < c_hi) ATT_LOAD(c + 1);
                const LAS unsigned char* kb = lds + (unsigned)cur * 32768u; const LAS unsigned char* vb = kb + 16384;
#pragma unroll
                for (int kt = 0; kt < 2; ++kt) {
                    const int kspan0 = 64 * c + 32 * kt, qs = 128 + 32 * qh;
                    if (kspan0 + 31 < qs - 128 || kspan0 > qs + 31 + 128) continue;
                    f32x16 sacc;
#pragma unroll
                    for (int i = 0; i < 16; ++i) sacc[i] = 0.f;
#pragma unroll
                    for (int s = 0; s < 8; ++s) { const bf16x8 kf = *(const LAS bf16x8*)(kb + kt * 8192 + 256u * r + 16u * ((unsigned)(2 * s + h) ^ xr));
                        sacc = __builtin_amdgcn_mfma_f32_32x32x16_bf16(kf, qf[s], sacc, 0, 0, 0); }
                    const int ib = kspan0 + 4 * h - (qs + r) + 192;
                    const LAS float* tb = tab + hq * 384 + ib;
                    float mx = -3.0e38f;
#pragma unroll
                    for (int i = 0; i < 16; ++i) { const int d = (i & 3) + 8 * (i >> 2); const int rel = ib + d - 192; const float bv = tb[d];
                        const float sv = (rel >= -128 && rel <= 128) ? sacc[i] + bv : -1.0e30f; sacc[i] = sv; mx = fmaxf(mx, sv); }
                    mx = fmaxf(mx, __shfl_xor(mx, 32));
                    const float m_new = fmaxf(m_run, mx);
                    if (__any(m_new > m_run)) {
                        const float alpha = __builtin_amdgcn_exp2f(m_run - m_new); m_run = m_new; l_run *= alpha;
#pragma unroll
                        for (int cc = 0; cc < 4; ++cc)
#pragma unroll
                            for (int i = 0; i < 16; ++i) O[cc][i] *= alpha; }
                    float ps = 0.f;
#pragma unroll
                    for (int i = 0; i < 16; ++i) { const float p = __builtin_amdgcn_exp2f(sacc[i] - m_run); sacc[i] = p; ps += p; }
                    l_run += ps;
                    bf16x8 pf[2];
#pragma unroll
                    for (int s2 = 0; s2 < 2; ++s2) { u32x4 w; w.x = pk2(sacc[8 * s2 + 0], sacc[8 * s2 + 1]); w.y = pk2(sacc[8 * s2 + 2], sacc[8 * s2 + 3]); w.z = pk2(sacc[8 * s2 + 4], sacc[8 * s2 + 5]); w.w = pk2(sacc[8 * s2 + 6], sacc[8 * s2 + 7]);
                        pf[s2] = __builtin_bit_cast(bf16x8, w); }
#pragma unroll
                    for (int cc = 0; cc < 4; ++cc)
#pragma unroll
                        for (int s2 = 0; s2 < 2; ++s2) {
                            const unsigned row0 = 16u * s2 + 4u * h + tq, ch = 4u * cc + 2u * tblk + (tp >> 1);
                            const s16x4 lo4 = tr_read(vb + kt * 8192 + off_b(row0, ch) + 8u * (tp & 1));
                            const s16x4 hi4 = tr_read(vb + kt * 8192 + off_b(row0 + 8u, ch) + 8u * (tp & 1));
                            const bf16x8 vf = __builtin_shufflevector(lo4, hi4, 0, 1, 2, 3, 4, 5, 6, 7);
                            O[cc] = __builtin_amdgcn_mfma_f32_32x32x16_bf16(vf, pf[s2], O[cc], 0, 0, 0);
                        }
                }
                if (c < c_hi) ATT_STORE(cur ^ 1);
                __syncthreads();
            }
#undef ATT_LOAD
#undef ATT_STORE
            const float linv = 1.0f / (l_run + __shfl_xor(l_run, 32));
            unsigned char* op = (unsigned char*)AO + (tokbase + qpos) * D + hq * HD + 4 * h;
#pragma unroll
            for (int cc = 0; cc < 4; ++cc)
#pragma unroll
                for (int ig = 0; ig < 4; ++ig) *(unsigned*)(op + 32 * cc + 8 * ig) = pk4_fp8(O[cc][4 * ig + 0] * linv, O[cc][4 * ig + 1] * linv, O[cc][4 * ig + 2] * linv, O[cc][4 * ig + 3] * linv);
        }
        }
        if (BOTH(4)) GRID_BAR();
    }

    if (IN(5)) { REP(5) {
        pg8::DenseSched S; S.init(AO, Wo, T, D, D / 2, D / 2, G, bx);
        pg8::EpiRes E{args.in[I_X], OUT, D, W8_INV};
        pg8::gemm_phase<pg8::EpiRes, pg8::DenseSched, 1>(lds + RING_OFF, pg8::Gemm{D / 2, D / 2, D / 128}, S, E);
        }
        if (BOTH(5)) GRID_BAR();
    }
    if (IN(6)) { REP(6) {
        rms_phase<true>(OUT, args.in[I_FFNN], Hb, gw, NGW, lane, tab_sa);
        }
        if (BOTH(6)) GRID_BAR();
    }
    if (IN(7)) { REP(7) {
        pg8::DenseSched S; S.init(Hb, (const bf16_t*)Wgu8, T, 2 * FF, D / 2, D / 2, G, bx);
        pg8::EpiSwiGLUi8 E{ACT, FF, FF / 128, tab_sa, tab_sw, 1};
        pg8::gemm_phase<pg8::EpiSwiGLUi8, pg8::DenseSched, 2>(lds + RING_OFF, pg8::Gemm{D / 2, D / 2, D / 128}, S, E);
        }
        if (BOTH(7)) GRID_BAR();
    }
    if (IN(8)) { REP(8) {
        pg8::DenseSched S; S.init(ACT, Wd, T, D, FF / 2, FF / 2, G, bx);
        pg8::EpiRes E{OUT, OUT, D, W8_INV};
        pg8::gemm_phase<pg8::EpiRes, pg8::DenseSched, 1>(lds + RING_OFF, pg8::Gemm{FF / 2, FF / 2, FF / 128, FF / 128, FF / 128}, S, E);
        }
        if (BOTH(8)) GRID_BAR();
    }
    if (IN(9)) { REP(9) {
        rms_phase<true>(OUT, args.in[I_MIXN] + D, Hb, gw, NGW, lane, tab_sa);
        }
        if (BOTH(9)) GRID_BAR();
    }
    if (IN(10)) { REP(10) {
        pg8::DenseSched S; S.init(Hb, (const bf16_t*)Win8, T, D, D / 2, D / 2, G, bx);
        pg8::EpiBf16i8 E{Ub, D, tab_sa, tab_sw + 2 * FF + QKVD};
        pg8::gemm_phase<pg8::EpiBf16i8, pg8::DenseSched, 2>(lds + RING_OFF, pg8::Gemm{D / 2, D / 2, D / 128}, S, E);
        }
        if (BOTH(10)) GRID_BAR();
    }
    if (IN(11)) { REP(11) {
        for (int idx = bx * (NWAVES * 64) + tid; idx < (T / 32) * (D / 8); idx += G * NWAVES * 64) {
            const int rb = idx >> 8, c8 = idx & 255, grp = c8 >> 6, h = 1 << grp;
            const int t0 = rb * 32, b = t0 >> 13, tt0 = t0 & (SEQ - 1);
            const bf16_t* up = Ub + ((size_t)b * SEQ) * D + c8 * 8;
            bf16_t* dp = DDb + ((size_t)b * SEQ) * D + c8 * 8;
            float a[8];
#pragma unroll
            for (int i = 0; i < 8; ++i) a[i] = 0.f;
            { int lo_ = tt0 - h; lo_ = lo_ < 0 ? 0 : lo_; int hi_ = tt0 + h; hi_ = hi_ > SEQ ? SEQ : hi_;
              for (int j = lo_; j < hi_; ++j) { const u32x4 w = *(const u32x4*)(up + (size_t)j * D);
                  a[0] += bf_lo(w.x); a[1] += bf_hi(w.x); a[2] += bf_lo(w.y); a[3] += bf_hi(w.y); a[4] += bf_lo(w.z); a[5] += bf_hi(w.z); a[6] += bf_lo(w.w); a[7] += bf_hi(w.w); } }
            for (int sb = 0; sb < 4; ++sb) {
                const int tb = tt0 + 8 * sb;
                u32x4 wc[8], wa[8], wsb[8];
#pragma unroll
                for (int j = 0; j < 8; ++j) { const int tt = tb + j; int ra = tt + h; ra = ra > SEQ - 1 ? SEQ - 1 : ra; int rs_ = tt - h; rs_ = rs_ < 0 ? 0 : rs_;
                    wc[j] = *(const u32x4*)(up + (size_t)tt * D); wa[j] = *(const u32x4*)(up + (size_t)ra * D); wsb[j] = *(const u32x4*)(up + (size_t)rs_ * D); }
#pragma unroll
                for (int j = 0; j < 8; ++j) { const int tt = tb + j; int lo_ = tt - h; lo_ = lo_ < 0 ? 0 : lo_; int hi_ = tt + h; hi_ = hi_ > SEQ ? SEQ : hi_;
                    const float inv = 1.0f / (float)(hi_ - lo_); const u32x4 w = wc[j];
                    u32x4 o; o.x = pk2(a[0] * inv - bf_lo(w.x), a[1] * inv - bf_hi(w.x)); o.y = pk2(a[2] * inv - bf_lo(w.y), a[3] * inv - bf_hi(w.y));
                    o.z = pk2(a[4] * inv - bf_lo(w.z), a[5] * inv - bf_hi(w.z)); o.w = pk2(a[6] * inv - bf_lo(w.w), a[7] * inv - bf_hi(w.w));
                    *(u32x4*)(dp + (size_t)tt * D) = o;
                    const float ma = (tt + h < SEQ) ? 1.f : 0.f, ms = (tt - h >= 0) ? 1.f : 0.f; const u32x4 p = wa[j], q = wsb[j];
                    a[0] += ma * bf_lo(p.x) - ms * bf_lo(q.x); a[1] += ma * bf_hi(p.x) - ms * bf_hi(q.x); a[2] += ma * bf_lo(p.y) - ms * bf_lo(q.y); a[3] += ma * bf_hi(p.y) - ms * bf_hi(q.y);
                    a[4] += ma * bf_lo(p.z) - ms * bf_lo(q.z); a[5] += ma * bf_hi(p.z) - ms * bf_hi(q.z); a[6] += ma * bf_lo(p.w) - ms * bf_lo(q.w); a[7] += ma * bf_hi(p.w) - ms * bf_hi(q.w); }
            }
        }
        }
        if (BOTH(11)) GRID_BAR();
    }
    if (IN(13)) { REP(13) {
        pg8::DenseSched S; S.init(DDb, Wpt, T, D, D, D, G, bx);
        pg8::EpiRes E{OUT, OUT, D, 1.0f};
        pg8::gemm_phase<pg8::EpiRes, pg8::DenseSched>(lds + RING_OFF, pg8::Gemm{D, D, D / 64}, S, E);
        }
        if (BOTH(13)) GRID_BAR();
    }
    if (IN(14)) { REP(14) {
        LAS float* rwl = (LAS float*)(lds + RING_OFF);
        LAS int* lcnt = (LAS int*)(lds + RING_OFF + 65536);
        const float* rw = args.in[I_RW]; const float* rb = args.in[I_RB];
        for (int rr = tid; rr < D; rr += NWAVES * 64) { const f32x4 a = *(const f32x4*)(rw + rr * 8), b2 = *(const f32x4*)(rw + rr * 8 + 4);
            rwl[0 * D + rr] = a.x; rwl[1 * D + rr] = a.y; rwl[2 * D + rr] = a.z; rwl[3 * D + rr] = a.w; rwl[4 * D + rr] = b2.x; rwl[5 * D + rr] = b2.y; rwl[6 * D + rr] = b2.z; rwl[7 * D + rr] = b2.w; }
        if (tid < 8) lcnt[tid] = 0;
        __syncthreads();
        const float* gain = args.in[I_FFNN] + D;
        if (G == 256) {
            f32x4 gg[8], va[8], vb[8];
#pragma unroll
            for (int j = 0; j < 8; ++j) gg[j] = ((const f32x4*)gain + lane)[64 * j];
#define P13_ROW(v, t_) do { const int t = (t_); float s = 0.f; \
                _Pragma("unroll") for (int j = 0; j < 8; ++j) s += (v[j].x * v[j].x + v[j].y * v[j].y) + (v[j].z * v[j].z + v[j].w * v[j].w); \
                const float rs = 1.0f / sqrtf(wave_sum(s) * (1.f / D) + EPS); \
                unsigned* o4 = (unsigned*)((unsigned char*)Hb + (size_t)t * D) + lane;        \
                _Pragma("unroll") for (int j = 0; j < 8; ++j) { v[j] = v[j] * rs * gg[j]; o4[64 * j] = pk4_fp8(v[j].x, v[j].y, v[j].z, v[j].w); } \
                float lg[8]; \
                _Pragma("unroll") for (int e = 0; e < 8; ++e) { float a = 0.f; \
                    _Pragma("unroll") for (int j = 0; j < 8; ++j) { const f32x4 w4 = *(const LAS f32x4*)(rwl + e * D + 4 * (lane + 64 * j)); a += (v[j].x * w4.x + v[j].y * w4.y) + (v[j].z * w4.z + v[j].w * w4.w); } \
                    lg[e] = wave_sum(a) + rb[e]; } \
                int e0 = 0; float v0 = lg[0]; \
                _Pragma("unroll") for (int e = 1; e < 8; ++e) if (lg[e] > v0) { v0 = lg[e]; e0 = e; } \
                int e1 = -1; float v1 = -3.0e38f; \
                _Pragma("unroll") for (int e = 0; e < 8; ++e) if (e != e0 && lg[e] > v1) { v1 = lg[e]; e1 = e; } \
                const float w0 = 1.0f / (1.0f + __expf(v1 - v0)), w1 = 1.0f - w0; \
                if (lane == 0) { tab_te[t] = e0 | (e1 << 8); tab_tw[2 * t] = w0; tab_tw[2 * t + 1] = w1; __hip_atomic_fetch_add(&lcnt[e0], 1, __ATOMIC_RELAXED, __HIP_MEMORY_SCOPE_WORKGROUP); __hip_atomic_fetch_add(&lcnt[e1], 1, __ATOMIC_RELAXED, __HIP_MEMORY_SCOPE_WORKGROUP); } } while (0)
            const int tw0 = 64 * bx + 8 * wave;
            rms_load(va, OUT, tw0, lane);
            for (int i = 0; i < 8; i += 2) {
                rms_load(vb, OUT, tw0 + i + 1, lane);
                P13_ROW(va, tw0 + i);
                if (i + 2 < 8) rms_load(va, OUT, tw0 + i + 2, lane);
                P13_ROW(vb, tw0 + i + 1);
            }
#undef P13_ROW
        }
        __syncthreads();
        if (tid < 8) tab_cnt[bx * 8 + tid] = lcnt[tid];
        }
        if (BOTH(14)) GRID_BAR();
    }
    if (IN(15)) { REP(15) {
        LAS int* arr = (LAS int*)(lds + RING_OFF);
        LAS int* ltot = arr + 2048; LAS int* lpre = ltot + 8; LAS int* lseg = lpre + 8; LAS int* lslot = lseg + 16;
        if (G == 256) {
            if (tid < 256) {
#pragma unroll
                for (int e = 0; e < 8; ++e) arr[e * 256 + tid] = tab_cnt[tid * 8 + e];
            }
            __syncthreads();
            { const int e = wave; int tot = 0, pre = 0;
#pragma unroll
              for (int k = 0; k < 4; ++k) { const int idx = lane * 4 + k; const int v = arr[e * 256 + idx]; tot += v; pre += (idx < bx) ? v : 0; }
              tot = wave_sum_i(tot); pre = wave_sum_i(pre);
              if (lane == 0) { ltot[e] = tot; lpre[e] = pre; } }
            __syncthreads();
            if (tid == 0) { int s = 0; for (int e = 0; e < 8; ++e) { lseg[e] = s; s += ((ltot[e] + 255) >> 8) << 8; } lseg[8] = s; }
            __syncthreads();
            if (bx == 0 && tid < 160) { const int slot = tid * 256; int e = 0;
#pragma unroll
                for (int k = 0; k < 8; ++k) if (slot >= lseg[k] && slot < lseg[k + 1]) e = k;
                tab_tile[tid] = e; if (tid == 0) tab_tile[255] = lseg[8] >> 8; }
            if (wave == 0) {
                const int t = 64 * bx + lane; const int pk = tab_te[t]; const int e0 = pk & 255, e1 = pk >> 8; int s0 = 0, s1 = 0;
                const unsigned long long lt = (1ull << lane) - 1ull;
#pragma unroll
                for (int e = 0; e < 8; ++e) { const int base = lseg[e] + lpre[e]; const unsigned long long m0 = __ballot(e0 == e), m1 = __ballot(e1 == e);
                    const int r0 = __popcll(m0 & lt), r1 = __popcll(m0) + __popcll(m1 & lt);
                    if (e0 == e) s0 = base + r0; if (e1 == e) s1 = base + r1; }
                tab_slot[2 * t] = s0; tab_slot[2 * t + 1] = s1; tab_wslot[s0] = tab_tw[2 * t]; tab_wslot[s1] = tab_tw[2 * t + 1];
                lslot[2 * lane] = s0; lslot[2 * lane + 1] = s1;
            }
            __syncthreads();
            for (int i = 0; i < 8; ++i) { const int tl = 8 * wave + i, t = 64 * bx + tl; const int s0 = lslot[2 * tl], s1 = lslot[2 * tl + 1];
                const u32x4* src = (const u32x4*)((unsigned char*)Hb + (size_t)t * D) + lane; u32x4* d0 = (u32x4*)((unsigned char*)HS + (size_t)s0 * D) + lane; u32x4* d1 = (u32x4*)((unsigned char*)HS + (size_t)s1 * D) + lane;
#pragma unroll
                for (int k = 0; k < 2; ++k) { const u32x4 w = src[64 * k]; d0[64 * k] = w; d1[64 * k] = w; } }
        }
        }
        if (BOTH(15)) GRID_BAR();
    }
    if (IN(16)) { REP(16) {
        LAS int* lt = (LAS int*)(lds + LTAB_OFF);
        if (tid < 256) lt[tid] = tab_tile[tid];
        __syncthreads();
        int nM = __builtin_amdgcn_readfirstlane(lt[255]); nM = nM < 0 ? 0 : (nM > SLOTS_MAX / 256 ? SLOTS_MAX / 256 : nM);
        pg8::MoeSched S; S.init(HS, Wmgu, nM, 2 * FFE, D / 2, D / 2, lt, G, bx);
        pg8::EpiSwiGLU8 E{(unsigned char*)ACTM, FFE, W8_INV, FFE / 128};
        pg8::gemm_phase<pg8::EpiSwiGLU8, pg8::MoeSched, true>(lds + RING_OFF, pg8::Gemm{D / 2, D / 2, D / 128}, S, E);
        }
        if (BOTH(16)) GRID_BAR();
    }
    if (IN(17)) { REP(17) {
        LAS int* lt = (LAS int*)(lds + LTAB_OFF);
        if (tid < 256) lt[tid] = tab_tile[tid];
        __syncthreads();
        int nM = __builtin_amdgcn_readfirstlane(lt[255]); nM = nM < 0 ? 0 : (nM > SLOTS_MAX / 256 ? SLOTS_MAX / 256 : nM);
        const int nMain = nM < TAIL_PM0 ? nM : TAIL_PM0, R = nM - nMain;
        { pg8::MoeSched S; S.init(ACTM, Wmd, nMain, D, FFE / 2, FFE / 2, lt, G, bx);
          pg8::EpiRowScaleBf16 E{HS, D, tab_wslot, W8_INV};
          pg8::gemm_phase<pg8::EpiRowScaleBf16, pg8::MoeSched, true>(lds + RING_OFF, pg8::Gemm{FFE / 2, FFE / 2, FFE / 128, FFE / 128, FFE / 128}, S, E); }
        if (R > 0) { const int Sk = tail_split(R);
          pg8::MoeTailSched S; S.init(ACTM, Wmd, TAIL_PM0, R, Sk, D, FFE / 2, FFE / 2, lt, G, bx);
          pg8::EpiPartF32 E{(float*)(ws + WS_PART), tab_wslot, W8_INV};
          pg8::gemm_phase<pg8::EpiPartF32, pg8::MoeTailSched, true>(lds + RING_OFF, pg8::Gemm{FFE / 2, FFE / 2, (FFE / 128) / Sk, FFE / 128, FFE / 128}, S, E); }
        }
        if (BOTH(17)) GRID_BAR();
    }
    if (IN(18)) {
        const bool bad = (N_LAUNCHES == 1) && (__hip_atomic_load((unsigned*)(ws + WS_CTL) + CW_BAR + XB_TMO, RLX_AGENT) != 0u);
#define P17_LOAD(ya, yb, ov, t_, sa, sb) do { const int _t = (t_); const int _s0 = tab_slot[2 * _t], _s1 = tab_slot[2 * _t + 1]; sa = _s0; sb = _s1; \
            const f32x4* _op = (const f32x4*)(OUT + (size_t)_t * D) + 2 * lane; const u32x4* _y0 = (const u32x4*)(HS + (size_t)_s0 * D) + lane; const u32x4* _y1 = (const u32x4*)(HS + (size_t)_s1 * D) + lane; \
            _Pragma("unroll") for (int k = 0; k < 4; ++k) { ya[k] = _y0[64 * k]; yb[k] = _y1[64 * k]; ov[2 * k] = _op[128 * k]; ov[2 * k + 1] = _op[128 * k + 1]; } } while (0)
#define P17_TAIL(yv, sl) do { if ((sl) >= TAIL_PM0 * 256) { const int _ut0 = (((sl) >> 8) - TAIL_PM0) * 8, _r = (sl) & 255; \
            _Pragma("unroll") for (int k = 0; k < 4; ++k) { const int _col = 8 * lane + 512 * k; const float* _pp = PART + ((size_t)(_ut0 + (_col >> 8)) * Sk) * 65536 + _r * 256 + (_col & 255); \
                f32x4 _a0 = {0.f, 0.f, 0.f, 0.f}, _a1 = {0.f, 0.f, 0.f, 0.f}; for (int _kp = 0; _kp < Sk; ++_kp) { _a0 += *(const f32x4*)(_pp + (size_t)_kp * 65536); _a1 += *(const f32x4*)(_pp + (size_t)_kp * 65536 + 4); } \
                u32x4 _w; _w.x = pk2(_a0.x, _a0.y); _w.y = pk2(_a0.z, _a0.w); _w.z = pk2(_a1.x, _a1.y); _w.w = pk2(_a1.z, _a1.w); yv[k] = _w; } } } while (0)
#define P17_FIN(ya, yb, ov, t_, sa, sb) do { f32x4* _op = (f32x4*)(OUT + (size_t)(t_) * D) + 2 * lane; P17_TAIL(ya, sa); P17_TAIL(yb, sb); \
            _Pragma("unroll") for (int k = 0; k < 4; ++k) { const u32x4 a = ya[k], c = yb[k]; f32x4 o0 = ov[2 * k], o1 = ov[2 * k + 1]; \
                o0.x += bf_lo(a.x) + bf_lo(c.x); o0.y += bf_hi(a.x) + bf_hi(c.x); o0.z += bf_lo(a.y) + bf_lo(c.y); o0.w += bf_hi(a.y) + bf_hi(c.y); \
                o1.x += bf_lo(a.z) + bf_lo(c.z); o1.y += bf_hi(a.z) + bf_hi(c.z); o1.z += bf_lo(a.w) + bf_lo(c.w); o1.w += bf_hi(a.w) + bf_hi(c.w); \
                if (bad) { const float q = __builtin_nanf(""); o0 = (f32x4){q, q, q, q}; o1 = o0; } \
                _op[128 * k] = o0; _op[128 * k + 1] = o1; } } while (0)
        { u32x4 yaA[4], ybA[4], yaB[4], ybB[4]; f32x4 ovA[8], ovB[8]; int saA, sbA, saB, sbB;
          const float* PART = (const float*)(ws + WS_PART);
          int nMt = tab_tile[255]; nMt = nMt > SLOTS_MAX / 256 ? SLOTS_MAX / 256 : nMt; const int Sk = tail_split(nMt - TAIL_PM0);
          int t = gw;
          if (t < T) { P17_LOAD(yaA, ybA, ovA, t, saA, sbA);
            for (;;) {
                const int tn = t + NGW; if (tn < T) P17_LOAD(yaB, ybB, ovB, tn, saB, sbB);
                P17_FIN(yaA, ybA, ovA, t, saA, sbA);
                if (tn >= T) break;
                t = tn + NGW; if (t < T) P17_LOAD(yaA, ybA, ovA, t, saA, sbA);
                P17_FIN(yaB, ybB, ovB, tn, saB, sbB);
                if (t >= T) break;
            } } }
#undef P17_LOAD
#undef P17_FIN
#undef P17_TAIL
    }
#undef IN
#undef BOTH
#undef GRID_BAR
}

extern "C" void kernel_launch(void* const* d_in, const int* in_sizes, int n_in, void* d_out, int out_size, void* d_ws, size_t ws_size, hipStream_t stream) {
    static int grid = 0;
    if (grid == 0) {
        if (n_in != 21 || in_sizes[0] != T * D || out_size != T * D || ws_size < WS_END) { fprintf(stderr, "kernel_launch: unexpected shapes (n_in %d, in0 %d, out %d, ws %zu need %zu); nothing launched\n", n_in, n_in > 0 ? in_sizes[0] : -1, out_size, ws_size, (size_t)WS_END); grid = -1; return; }
        int dev = 0, cus = 0, per_cu = 0;
        if (hipGetDevice(&dev) != hipSuccess || hipDeviceGetAttribute(&cus, hipDeviceAttributeMultiprocessorCount, dev) != hipSuccess) { fprintf(stderr, "kernel_launch: device query failed\n"); grid = -1; return; }
        if (hipFuncSetAttribute((const void*)fwd_kernel, hipFuncAttributeMaxDynamicSharedMemorySize, LDS_BYTES) != hipSuccess) { fprintf(stderr, "kernel_launch: hipFuncSetAttribute failed\n"); grid = -1; return; }
        if (hipOccupancyMaxActiveBlocksPerMultiprocessor(&per_cu, (const void*)fwd_kernel, NWAVES * 64, LDS_BYTES) != hipSuccess || per_cu < 1) fprintf(stderr, "kernel_launch: note: occupancy query reports %d\n", per_cu);
        (void)hipGetLastError();
        grid = cus;
        if (grid != 256) fprintf(stderr, "kernel_launch: %d CUs; the MoE routing phases need a 256-workgroup grid\n", grid);
    }
    if (grid < 0) return;
    if (hipMemsetAsync((char*)d_ws + WS_CTL, 0, CTL_ZERO_BYTES, stream) != hipSuccess) { fprintf(stderr, "kernel_launch: memset failed\n"); return; }
    Args a{};
    for (int i = 0; i < 21; ++i) a.in[i] = (const float*)d_in[i];
    a.out = (float*)d_out; a.ws = (unsigned char*)d_ws;
    for (int li = 0; li < N_LAUNCHES; ++li) {
        a.ph_lo = (N_LAUNCHES == 1) ? 0 : li; a.ph_hi = (N_LAUNCHES == 1) ? NPH : li + 1;
        hipLaunchKernelGGL(fwd_kernel, dim3(grid), dim3(NWAVES * 64), LDS_BYTES, stream, a);
        const hipError_t le = hipPeekAtLastError();
        if (le != hipSuccess) { fprintf(stderr, "kernel_launch: launch %d failed: %s\n", li, hipGetErrorName(le)); break; }
    }
}
```

```cpp
#include <hip/hip_runtime.h>
#include <cstdio>
#include <cstdint>

#ifndef PROBE_MASK
#define PROBE_MASK (0)
#endif
#ifndef ACTM_PITCH
#define ACTM_PITCH 8192
#endif
#ifndef MK_N_LAUNCHES
#define MK_N_LAUNCHES 1
#endif

#define GAS __attribute__((address_space(1)))
#define LAS __attribute__((address_space(3)))
typedef unsigned short bf16_t;
typedef short bf16x8 __attribute__((ext_vector_type(8)));
typedef short s16x4 __attribute__((ext_vector_type(4)));
typedef float f32x2 __attribute__((ext_vector_type(2)));
typedef float f32x4 __attribute__((ext_vector_type(4)));
typedef float f32x16 __attribute__((ext_vector_type(16)));
typedef unsigned u32x2 __attribute__((ext_vector_type(2)));
typedef unsigned u32x4 __attribute__((ext_vector_type(4)));
typedef __bf16 bf16x2v __attribute__((ext_vector_type(2)));
typedef GAS unsigned gu32;
typedef int i32x4 __attribute__((ext_vector_type(4)));
typedef int i32x8 __attribute__((ext_vector_type(8)));

__device__ __forceinline__ unsigned pk2(float lo, float hi) { f32x2 v = {lo, hi}; bf16x2v b = __builtin_convertvector(v, bf16x2v); return __builtin_bit_cast(unsigned, b); }
__device__ __forceinline__ unsigned pk4_fp8(float a, float b, float c, float d) {
    a = __builtin_amdgcn_fmed3f(a, -448.f, 448.f); b = __builtin_amdgcn_fmed3f(b, -448.f, 448.f); c = __builtin_amdgcn_fmed3f(c, -448.f, 448.f); d = __builtin_amdgcn_fmed3f(d, -448.f, 448.f);
    int w = __builtin_amdgcn_cvt_pk_fp8_f32(a, b, 0, false); w = __builtin_amdgcn_cvt_pk_fp8_f32(c, d, w, true); return (unsigned)w; }
__device__ __forceinline__ float bf_lo(unsigned w) { return __uint_as_float(w << 16); }
__device__ __forceinline__ float bf_hi(unsigned w) { return __uint_as_float(w & 0xffff0000u); }

constexpr int BATCH = 2, SEQ = 8192, T = BATCH * SEQ, D = 2048, NH = 16, NKV = 4, HD = 128, QKVD = 3072;
constexpr int FF = 5632, NE = 8, FFE = 7168;
constexpr int FFEP = ACTM_PITCH;
constexpr int SLOTS_MAX = 2 * T + NE * 256;
constexpr float EPS = 1e-6f;
constexpr float LOG2E = 1.4426950408889634f;
constexpr float W8_SCALE = 128.f, W8_INV = 1.f / 128.f;

__host__ __device__ __forceinline__ unsigned tile_off16k(int r7, int c7) { const int st = (r7 >> 4) * 2 + (c7 >> 6), ob = (r7 & 15) * 64 + (c7 & 63); return (unsigned)(st * 1024 + (ob ^ (((ob >> 9) & 1) << 5))); }
__host__ __device__ __forceinline__ size_t tiled_off(int row, int cb, int nkt) { return ((size_t)((row >> 7) * nkt + (cb >> 7)) << 14) + tile_off16k(row & 127, cb & 127); }
__host__ __device__ __forceinline__ int inv_perm32(int w) { return 16 * ((w >> 2) & 1) + 4 * (w >> 3) + (w & 3); }

namespace pg8 {
constexpr int BM = 256, BK = 64, HALF = 128, HTB = HALF * BK * 2, STAGE_BYTES = 8 * HTB, NXCD = 8;
__host__ __device__ __forceinline__ int lds_byte(int r, int c) { const int st = (r >> 4) * 2 + (c >> 5), rr = r & 15, cc = c & 31, ob = rr * 64 + cc * 2; return st * 1024 + (ob ^ (((ob >> 9) & 1) << 5)); }
__host__ __device__ __forceinline__ void stage_rc(int b, int& R, int& C) { const int st = b / 1024, sb = b % 1024, swz = sb ^ (((sb >> 9) & 1) << 5); R = (st >> 1) * 16 + swz / 64; C = (st & 1) * 32 + (swz % 64) / 2; }
__host__ __device__ __forceinline__ int perm32(int rho) { const int n = rho >> 4, i = rho & 15; return 8 * (i >> 2) + 4 * n + (i & 3); }

struct Unit { int pm, pn, aux; const char* a; const char* b; };
struct Gemm { int lda, ldb, nt, nktA, nktB; };

template <int WGM> struct TileOrder {
    int nM, nN, nwg, G, c;
    __device__ __forceinline__ void init(int nM_, int nN_, int G_, int c_) { nM = nM_; nN = nN_; nwg = nM * nN; G = G_; c = c_; }
    __device__ __forceinline__ bool tile(int i, int& pm, int& pn) const {
        const long L = (long)i * G + c; if (L >= nwg) return false;
        int wgid = (int)L; { const int q = nwg / NXCD, r = nwg % NXCD, xcd = wgid % NXCD, off = wgid / NXCD; wgid = (xcd < r ? xcd * (q + 1) : r * (q + 1) + (xcd - r) * q) + off; }
        const int nig = WGM * nN, gid = wgid / nig, fm = gid * WGM, gsz = (nM - fm) < WGM ? (nM - fm) : WGM;
        pm = fm + ((wgid % nig) % gsz); pn = (wgid % nig) / gsz; return true;
    }
};
struct DenseSched {
    TileOrder<8> o; const char* A; const char* B; size_t astep, bstep;
    __device__ __forceinline__ void init(const bf16_t* A_, const bf16_t* B_, int M, int N, int lda, int ldb, int G, int c) { o.init(M / BM, N / BM, G, c); A = (const char*)A_; B = (const char*)B_; astep = (size_t)BM * lda * 2; bstep = (size_t)BM * ldb * 2; }
    __device__ __forceinline__ bool next(int i, Unit& u) const { if (!o.tile(i, u.pm, u.pn)) return false; u.a = A + (size_t)u.pm * astep; u.b = B + (size_t)u.pn * bstep; return true; }
};
struct WprodSched {
    int G, c; const char* A; const char* B;
    __device__ __forceinline__ void init(const bf16_t* A_, const bf16_t* B_, int G_, int c_) { G = G_; c = c_; A = (const char*)A_; B = (const char*)B_; }
    __device__ __forceinline__ bool next(int i, Unit& u) const { const int L = i * G + c; if (L >= 64) return false;
        const int g = L >> 4, pm = (L >> 1) & 7, pn = L & 1; u.pm = pm; u.pn = g * 2 + pn;
        u.a = A + ((size_t)pm * BM * D + (size_t)g * 512) * 2; u.b = B + ((size_t)(g * 512 + pn * BM) * 512) * 2; return true; }
};
struct MoeSched {
    TileOrder<8> o; const char* A; const char* B; size_t astep, bstep, estep; const LAS int* te;
    __device__ __forceinline__ void init(const bf16_t* A_, const bf16_t* B_, int nM, int nper, int lda, int ldb, const LAS int* te_, int G, int c) {
        o.init(nM, nper / BM, G, c); A = (const char*)A_; B = (const char*)B_; astep = (size_t)BM * lda * 2; bstep = (size_t)BM * ldb * 2; estep = (size_t)nper * ldb * 2; te = te_; }
    __device__ __forceinline__ bool next(int i, Unit& u) const { if (!o.tile(i, u.pm, u.pn)) return false;
        const int e = __builtin_amdgcn_readfirstlane(te[u.pm]); u.a = A + (size_t)u.pm * astep; u.b = B + (size_t)e * estep + (size_t)u.pn * bstep; return true; }
};

struct MoeTailSched {
    int nsu, S, pm0, G, c; const char* A; const char* B; size_t astep, bstep, estep, kbytes; const LAS int* te;
    __device__ __forceinline__ void init(const bf16_t* A_, const bf16_t* B_, int pm0_, int R, int S_, int nper, int lda, int ldb, const LAS int* te_, int G_, int c_) {
        nsu = R * 8 * S_; S = S_; pm0 = pm0_; G = G_; c = c_; A = (const char*)A_; B = (const char*)B_; astep = (size_t)BM * lda * 2; bstep = (size_t)BM * ldb * 2; estep = (size_t)nper * ldb * 2; kbytes = (size_t)(FFE / 128 / S_) * 16384; te = te_; }
    __device__ __forceinline__ bool next(int i, Unit& u) const { const int L = i * G + c; if (L >= nsu) return false;
        const int ut = L / S, kp = L - ut * S; u.pm = pm0 + (ut >> 3); u.pn = ut & 7; u.aux = L;
        const int e = __builtin_amdgcn_readfirstlane(te[u.pm]); u.a = A + (size_t)u.pm * astep + (size_t)kp * kbytes; u.b = B + (size_t)e * estep + (size_t)u.pn * bstep + (size_t)kp * kbytes; return true; }
};

struct EpiBf16 {
    static constexpr bool PERM = true;
    bf16_t* O; int ldc; const float* cscale; unsigned* cmax;
    __device__ __forceinline__ void operator()(const f32x4 (&acc)[2][2][4][2], const Unit& u, int wr, int wc, int fr, int fq) const {
        const int row0 = u.pm * BM + wr * 64 + fr, col0 = u.pn * BM + wc * 32 + 8 * fq;
        f32x4 sv[2][2];
#pragma unroll
        for (int bj = 0; bj < 2; ++bj)
#pragma unroll
            for (int n = 0; n < 2; ++n) sv[bj][n] = cscale ? *(const f32x4*)(cscale + col0 + bj * HALF + 4 * n) : (f32x4){1.f, 1.f, 1.f, 1.f};
#pragma unroll
        for (int ai = 0; ai < 2; ++ai)
#pragma unroll
            for (int m = 0; m < 4; ++m) { bf16_t* rowp = O + (size_t)(row0 + ai * HALF + m * 16) * ldc + col0;
                float mx = 0.f;
#pragma unroll
                for (int bj = 0; bj < 2; ++bj) { const f32x4 v0 = acc[ai][bj][m][0] * sv[bj][0], v1 = acc[ai][bj][m][1] * sv[bj][1];
                    u32x4 w; w.x = pk2(v0[0], v0[1]); w.y = pk2(v0[2], v0[3]); w.z = pk2(v1[0], v1[1]); w.w = pk2(v1[2], v1[3]);
                    mx = fmaxf(mx, fmaxf(fmaxf(fmaxf(fabsf(v0[0]), fabsf(v0[1])), fmaxf(fabsf(v0[2]), fabsf(v0[3]))), fmaxf(fmaxf(fabsf(v1[0]), fabsf(v1[1])), fmaxf(fabsf(v1[2]), fabsf(v1[3])))));
                    *(u32x4*)(rowp + bj * HALF) = w; }
                if (cmax) { mx = fmaxf(mx, __shfl_xor(mx, 16)); mx = fmaxf(mx, __shfl_xor(mx, 32)); if (fq == 0) atomicMax(cmax + row0 + ai * HALF + m * 16, __float_as_uint(mx)); } }
    }
};
__device__ __forceinline__ float swiglu1(float g, float u) { return g * u * __builtin_amdgcn_rcpf(1.0f + __builtin_amdgcn_exp2f(-LOG2E * g)); }
__device__ __forceinline__ f32x2 swiglu_pk(f32x2 g, f32x2 u, float ke, float ci) {
    const f32x2 t = g * ke; f32x2 e; e.x = __builtin_amdgcn_exp2f(t.x); e.y = __builtin_amdgcn_exp2f(t.y);
    const f32x2 d = e * ci + ci; f32x2 r; r.x = __builtin_amdgcn_rcpf(d.x); r.y = __builtin_amdgcn_rcpf(d.y);
    return (g * u) * r; }
struct EpiSwiGLU {
    static constexpr bool PERM = true;
    bf16_t* O; int ldc; int nkt;
    __device__ __forceinline__ void operator()(const f32x4 (&acc)[2][2][4][2], const Unit& u, int wr, int wc, int fr, int fq) const {
        const int row0 = u.pm * BM + wr * 64 + fr, col0 = u.pn * HALF + wc * 32 + 8 * fq;
        const unsigned toff = tile_off16k(wr * 64 + fr, (wc & 1) * 64 + 16 * fq);
#pragma unroll
        for (int ai = 0; ai < 2; ++ai)
#pragma unroll
            for (int m = 0; m < 4; ++m) { bf16_t* rowp = nkt ? (bf16_t*)((unsigned char*)O + (((size_t)((u.pm * 2 + ai) * nkt + 2 * u.pn + (wc >> 1))) << 14) + toff + m * 2048) : O + (size_t)(row0 + ai * HALF + m * 16) * ldc + col0;
                const f32x4 g0 = acc[ai][0][m][0], g1 = acc[ai][0][m][1], u0 = acc[ai][1][m][0], u1 = acc[ai][1][m][1];
                u32x4 w; w.x = pk2(swiglu1(g0[0], u0[0]), swiglu1(g0[1], u0[1])); w.y = pk2(swiglu1(g0[2], u0[2]), swiglu1(g0[3], u0[3]));
                w.z = pk2(swiglu1(g1[0], u1[0]), swiglu1(g1[1], u1[1])); w.w = pk2(swiglu1(g1[2], u1[2]), swiglu1(g1[3], u1[3]));
                *(u32x4*)rowp = w; }
    }
};
struct EpiBf16i8 {
    static constexpr bool PERM = true;
    bf16_t* O; int ldc; const float* sA; const float* sW;
    __device__ __forceinline__ void operator()(const f32x4 (&acc)[2][2][4][2], const Unit& u, int wr, int wc, int fr, int fq) const {
        const int row0 = u.pm * BM + wr * 64 + fr, col0 = u.pn * BM + wc * 32 + 8 * fq;
        f32x4 sv[2][2];
#pragma unroll
        for (int bj = 0; bj < 2; ++bj)
#pragma unroll
            for (int n = 0; n < 2; ++n) sv[bj][n] = *(const f32x4*)(sW + col0 + bj * HALF + 4 * n);
#pragma unroll
        for (int ai = 0; ai < 2; ++ai)
#pragma unroll
            for (int m = 0; m < 4; ++m) { const int row = row0 + ai * HALF + m * 16; const float ra = sA[row]; bf16_t* rowp = O + (size_t)row * ldc + col0;
#pragma unroll
                for (int bj = 0; bj < 2; ++bj) { const f32x4 v0 = __builtin_convertvector(__builtin_bit_cast(i32x4, acc[ai][bj][m][0]), f32x4) * (sv[bj][0] * ra), v1 = __builtin_convertvector(__builtin_bit_cast(i32x4, acc[ai][bj][m][1]), f32x4) * (sv[bj][1] * ra);
                    u32x4 w; w.x = pk2(v0[0], v0[1]); w.y = pk2(v0[2], v0[3]); w.z = pk2(v1[0], v1[1]); w.w = pk2(v1[2], v1[3]);
                    *(u32x4*)(rowp + bj * HALF) = w; } }
    }
};
struct EpiSwiGLUi8 {
    static constexpr bool PERM = true;
    bf16_t* O; int ldc; int nkt; const float* sA; const float* sW; int o8;
    __device__ __forceinline__ void operator()(const f32x4 (&acc)[2][2][4][2], const Unit& u, int wr, int wc, int fr, int fq) const {
        const int row0 = u.pm * BM + wr * 64 + fr, col0 = u.pn * HALF + wc * 32 + 8 * fq;
        const unsigned toff = tile_off16k(wr * 64 + fr, (wc & 1) * 64 + 16 * fq), toff8 = tile_off16k(wr * 64 + fr, wc * 32 + 8 * fq);
        const float* swp = sW + u.pn * BM + wc * 32 + 8 * fq;
        const f32x4 wg0 = *(const f32x4*)swp, wg1 = *(const f32x4*)(swp + 4), wu0 = *(const f32x4*)(swp + HALF), wu1 = *(const f32x4*)(swp + HALF + 4);
#pragma unroll
        for (int ai = 0; ai < 2; ++ai)
#pragma unroll
            for (int m = 0; m < 4; ++m) { const int row = row0 + ai * HALF + m * 16; const float ra = sA[row];
                bf16_t* rowp = nkt ? (bf16_t*)((unsigned char*)O + (((size_t)((u.pm * 2 + ai) * nkt + 2 * u.pn + (wc >> 1))) << 14) + toff + m * 2048) : O + (size_t)row * ldc + col0;
                const i32x4 ig0 = __builtin_bit_cast(i32x4, acc[ai][0][m][0]), ig1 = __builtin_bit_cast(i32x4, acc[ai][0][m][1]), iu0 = __builtin_bit_cast(i32x4, acc[ai][1][m][0]), iu1 = __builtin_bit_cast(i32x4, acc[ai][1][m][1]);
                const f32x4 g0 = __builtin_convertvector(ig0, f32x4) * wg0, g1 = __builtin_convertvector(ig1, f32x4) * wg1, u0 = __builtin_convertvector(iu0, f32x4) * wu0, u1 = __builtin_convertvector(iu1, f32x4) * wu1;
                if (o8) { const float ke = -LOG2E * ra, ci = 1.0f / (ra * ra);
                    const f32x2 a0 = swiglu_pk((f32x2){g0[0], g0[1]}, (f32x2){u0[0], u0[1]}, ke, ci), a1 = swiglu_pk((f32x2){g0[2], g0[3]}, (f32x2){u0[2], u0[3]}, ke, ci),
                                a2 = swiglu_pk((f32x2){g1[0], g1[1]}, (f32x2){u1[0], u1[1]}, ke, ci), a3 = swiglu_pk((f32x2){g1[2], g1[3]}, (f32x2){u1[2], u1[3]}, ke, ci);
                    u32x2 w8; w8.x = pk4_fp8(a0.x, a0.y, a1.x, a1.y); w8.y = pk4_fp8(a2.x, a2.y, a3.x, a3.y);
                    *(u32x2*)((unsigned char*)O + (((size_t)((u.pm * 2 + ai) * nkt + u.pn)) << 14) + toff8 + m * 2048) = w8; }
                else { const f32x4 G0 = g0 * ra, G1 = g1 * ra, U0 = u0 * ra, U1 = u1 * ra;
                u32x4 w; w.x = pk2(swiglu1(G0[0], U0[0]), swiglu1(G0[1], U0[1])); w.y = pk2(swiglu1(G0[2], U0[2]), swiglu1(G0[3], U0[3]));
                w.z = pk2(swiglu1(G1[0], U1[0]), swiglu1(G1[1], U1[1])); w.w = pk2(swiglu1(G1[2], U1[2]), swiglu1(G1[3], U1[3]));
                *(u32x4*)rowp = w; } }
    }
};
struct EpiSwiGLU8 {
    static constexpr bool PERM = true;
    unsigned char* O; int ldc; float sin; int nkt;
    __device__ __forceinline__ void operator()(const f32x4 (&acc)[2][2][4][2], const Unit& u, int wr, int wc, int fr, int fq) const {
        const int row0 = u.pm * BM + wr * 64 + fr, col0 = u.pn * HALF + wc * 32 + 8 * fq;
        const unsigned toff = tile_off16k(wr * 64 + fr, wc * 32 + 8 * fq);
#pragma unroll
        for (int ai = 0; ai < 2; ++ai)
#pragma unroll
            for (int m = 0; m < 4; ++m) { unsigned char* rowp = nkt ? O + (((size_t)((u.pm * 2 + ai) * nkt + u.pn)) << 14) + toff + m * 2048 : O + (size_t)(row0 + ai * HALF + m * 16) * ldc + col0;
                const f32x4 g0 = acc[ai][0][m][0], g1 = acc[ai][0][m][1], u0 = acc[ai][1][m][0], u1 = acc[ai][1][m][1];
                const float ke = -LOG2E * sin, ci = 1.0f / (sin * sin);
                const f32x2 a0 = swiglu_pk((f32x2){g0[0], g0[1]}, (f32x2){u0[0], u0[1]}, ke, ci), a1 = swiglu_pk((f32x2){g0[2], g0[3]}, (f32x2){u0[2], u0[3]}, ke, ci),
                            a2 = swiglu_pk((f32x2){g1[0], g1[1]}, (f32x2){u1[0], u1[1]}, ke, ci), a3 = swiglu_pk((f32x2){g1[2], g1[3]}, (f32x2){u1[2], u1[3]}, ke, ci);
                u32x2 w; w.x = pk4_fp8(a0.x, a0.y, a1.x, a1.y); w.y = pk4_fp8(a2.x, a2.y, a3.x, a3.y);
                *(u32x2*)rowp = w; }
    }
};
struct EpiRes {
    static constexpr bool PERM = false;
    const float* base; float* out; int ldc; float sc;
    __device__ __forceinline__ void operator()(const f32x4 (&acc)[2][2][4][2], const Unit& u, int wr, int wc, int fr, int fq) const {
        const int row0 = u.pm * BM + wr * 64 + fr, col0 = u.pn * BM + wc * 32 + 4 * fq;
#pragma unroll
        for (int ai = 0; ai < 2; ++ai)
#pragma unroll
            for (int m = 0; m < 4; ++m) { const size_t off = (size_t)(row0 + ai * HALF + m * 16) * ldc + col0;
#pragma unroll
                for (int bj = 0; bj < 2; ++bj)
#pragma unroll
                    for (int n = 0; n < 2; ++n) { const f32x4 bs = *(const f32x4*)(base + off + bj * HALF + n * 16); *(f32x4*)(out + off + bj * HALF + n * 16) = bs + acc[ai][bj][m][n] * sc; } }
    }
};
struct EpiResI8 {
    static constexpr bool PERM = false;
    const float* base; float* out; int ldc; const float* sA; const float* sW;
    __device__ __forceinline__ void operator()(const f32x4 (&acc)[2][2][4][2], const Unit& u, int wr, int wc, int fr, int fq) const {
        const int row0 = u.pm * BM + wr * 64 + fr, col0 = u.pn * BM + wc * 32 + 4 * fq;
        f32x4 sv[2][2];
#pragma unroll
        for (int bj = 0; bj < 2; ++bj)
#pragma unroll
            for (int n = 0; n < 2; ++n) sv[bj][n] = *(const f32x4*)(sW + col0 + bj * HALF + n * 16);
#pragma unroll
        for (int ai = 0; ai < 2; ++ai)
#pragma unroll
            for (int m = 0; m < 4; ++m) { const int row = row0 + ai * HALF + m * 16; const float ra = sA[row]; const size_t off = (size_t)row * ldc + col0;
#pragma unroll
                for (int bj = 0; bj < 2; ++bj)
#pragma unroll
                    for (int n = 0; n < 2; ++n) { const f32x4 bs = *(const f32x4*)(base + off + bj * HALF + n * 16);
                        *(f32x4*)(out + off + bj * HALF + n * 16) = bs + __builtin_convertvector(__builtin_bit_cast(i32x4, acc[ai][bj][m][n]), f32x4) * (sv[bj][n] * ra); } }
    }
};
struct EpiRowScaleBf16 {
    static constexpr bool PERM = true;
    bf16_t* O; int ldc; const float* rscale; float sin;
    __device__ __forceinline__ void operator()(const f32x4 (&acc)[2][2][4][2], const Unit& u, int wr, int wc, int fr, int fq) const {
        const int row0 = u.pm * BM + wr * 64 + fr, col0 = u.pn * BM + wc * 32 + 8 * fq;
#pragma unroll
        for (int ai = 0; ai < 2; ++ai)
#pragma unroll
            for (int m = 0; m < 4; ++m) { const int row = row0 + ai * HALF + m * 16; const float rs = rscale[row] * sin; bf16_t* rowp = O + (size_t)row * ldc + col0;
#pragma unroll
                for (int bj = 0; bj < 2; ++bj) { const f32x4 v0 = acc[ai][bj][m][0] * rs, v1 = acc[ai][bj][m][1] * rs;
                    u32x4 w; w.x = pk2(v0[0], v0[1]); w.y = pk2(v0[2], v0[3]); w.z = pk2(v1[0], v1[1]); w.w = pk2(v1[2], v1[3]);
                    *(u32x4*)(rowp + bj * HALF) = w; } }
    }
};

struct EpiPartF32 {
    static constexpr bool PERM = true;
    float* P; const float* rscale; float sin;
    __device__ __forceinline__ void operator()(const f32x4 (&acc)[2][2][4][2], const Unit& u, int wr, int wc, int fr, int fq) const {
        float* base = P + (size_t)u.aux * 65536; const int r0 = wr * 64 + fr, c0 = wc * 32 + 8 * fq;
#pragma unroll
        for (int ai = 0; ai < 2; ++ai)
#pragma unroll
            for (int m = 0; m < 4; ++m) { const int r = r0 + ai * HALF + m * 16; const float rs = rscale[u.pm * BM + r] * sin; float* rowp = base + r * 256 + c0;
#pragma unroll
                for (int bj = 0; bj < 2; ++bj)
#pragma unroll
                    for (int n = 0; n < 2; ++n) *(f32x4*)(rowp + bj * HALF + n * 4) = acc[ai][bj][m][n] * rs; }
    }
};

__device__ __forceinline__ i32x8 cat8(bf16x8 lo, bf16x8 hi) { const i32x4 a = __builtin_bit_cast(i32x4, lo), b = __builtin_bit_cast(i32x4, hi); return __builtin_shufflevector(a, b, 0, 1, 2, 3, 4, 5, 6, 7); }
template <class Epi, class Sched, int MODE = 0  , bool ALIGN_EPI = true>
__device__ __forceinline__ void gemm_phase(LAS unsigned char* lds, const Gemm g, const Sched& S, const Epi& E) {
    const int tid = threadIdx.x, wid = __builtin_amdgcn_readfirstlane(tid >> 6), lane = tid & 63, wr = wid >> 2, wc = wid & 3, fr = lane & 15, fq = lane >> 4;
    const int nt = g.nt;
    unsigned voffA[2], voffB[2];
#pragma unroll
    for (int i = 0; i < 2; ++i) { int R, C; stage_rc(tid * 16 + i * 8192, R, C); const int Rb = Epi::PERM ? ((R & ~31) + perm32(R & 31)) : R;
        voffA[i] = g.nktA ? (unsigned)(tid * 16 + i * 8192) : (unsigned)(R * g.lda + C) * 2u; voffB[i] = g.nktB ? (unsigned)(tid * 16 + i * 8192) : (unsigned)(Rb * g.ldb + C) * 2u; }
    const size_t kstepA = g.nktA ? (size_t)16384 : (size_t)(BK * 2), kstepB = g.nktB ? (size_t)16384 : (size_t)(BK * 2);
    const size_t hstepA = g.nktA ? (size_t)g.nktA * 16384 : (size_t)HALF * g.lda * 2, hstepB = g.nktB ? (size_t)g.nktB * 16384 : (size_t)HALF * g.ldb * 2;
    const unsigned ldsw = (unsigned)wid * 1024u;
    const int aoff = lds_byte(wr * 64 + fr, fq * 8), boff = lds_byte(wc * 32 + fr, fq * 8);
#define PG8_SA(b, h) (((b) * 2 + (h)) * HTB)
#define PG8_SB(b, h) ((4 + (b) * 2 + (h)) * HTB)
#define PG8_STAGE(bufoff, gbase, voff) do { const char* _gb = (const char*)(gbase); asm volatile("" : "+s"(_gb)); _Pragma("unroll") for (int _i = 0; _i < 2; ++_i) \
        { unsigned _vo = (voff)[_i]; asm volatile("" : "+v"(_vo)); __builtin_amdgcn_global_load_lds((const unsigned*)(_gb + _vo), (LAS unsigned*)(lds + (bufoff) + ldsw + _i * 8192), 16, 0, 0); } } while (0)
#define PG8_LDA(dst, b, h) do { _Pragma("unroll") for (int m = 0; m < 4; ++m) _Pragma("unroll") for (int k = 0; k < 2; ++k) dst[m][k] = *(const LAS bf16x8*)(lds + PG8_SA(b, h) + aoff + m * 2048 + k * 1024); } while (0)
#define PG8_LDB(dst, b, h) do { _Pragma("unroll") for (int n = 0; n < 2; ++n) _Pragma("unroll") for (int k = 0; k < 2; ++k) dst[n][k] = *(const LAS bf16x8*)(lds + PG8_SB(b, h) + boff + n * 2048 + k * 1024); } while (0)
#define PG8_MMA(ai, bj, At, Bt) do { __builtin_amdgcn_s_setprio(1); _Pragma("unroll") for (int m = 0; m < 4; ++m) _Pragma("unroll") for (int n = 0; n < 2; ++n) { \
        if constexpr (MODE == 1) { asm volatile("v_mfma_f32_16x16x128_f8f6f4 %0, %1, %2, %0" : "+v"(acc[ai][bj][m][n]) : "v"(cat8(Bt[n][0], Bt[n][1])), "v"(cat8(At[m][0], At[m][1]))); } \
        else if constexpr (MODE == 2) { _Pragma("unroll") for (int k = 0; k < 2; ++k) asm volatile("v_mfma_i32_16x16x64_i8 %0, %1, %2, %0" : "+v"(acc[ai][bj][m][n]) : "v"(Bt[n][k]), "v"(At[m][k])); } \
        else { _Pragma("unroll") for (int k = 0; k < 2; ++k) acc[ai][bj][m][n] = __builtin_amdgcn_mfma_f32_16x16x32_bf16(Bt[n][k], At[m][k], acc[ai][bj][m][n], 0, 0, 0); } } \
        __builtin_amdgcn_s_setprio(0); } while (0)
#define PG8_WAIT_V(n) asm volatile("s_waitcnt vmcnt(" #n ")" ::: "memory")
#define PG8_WAIT_L(n) asm volatile("s_waitcnt lgkmcnt(" #n ")" ::: "memory")
#define PG8_BAR __builtin_amdgcn_s_barrier()
#define PG8_SCHED __builtin_amdgcn_sched_barrier(0)
    Unit cur, nxt; int ui = 0;
    if (!S.next(0, cur)) return;
    f32x4 acc[2][2][4][2];
#pragma unroll
    for (int a = 0; a < 2; ++a)
#pragma unroll
        for (int b = 0; b < 2; ++b)
#pragma unroll
            for (int m = 0; m < 4; ++m)
#pragma unroll
                for (int n = 0; n < 2; ++n) acc[a][b][m][n] = (f32x4){0.f, 0.f, 0.f, 0.f};
    bf16x8 At[4][2], B0[2][2], B1[2][2];
    const char* cA = cur.a; const char* cB = cur.b;
    PG8_STAGE(PG8_SB(0, 0), cB, voffB); PG8_STAGE(PG8_SB(0, 1), cB + hstepB, voffB); PG8_STAGE(PG8_SA(0, 0), cA, voffA); PG8_STAGE(PG8_SA(0, 1), cA + hstepA, voffA);
    if (wr == 1) PG8_BAR;
    PG8_WAIT_V(2); PG8_BAR;
    PG8_STAGE(PG8_SB(1, 0), cB + kstepB, voffB); PG8_STAGE(PG8_SA(1, 0), cA + kstepA, voffA); PG8_STAGE(PG8_SB(1, 1), cB + hstepB + kstepB, voffB);
    PG8_WAIT_V(6); PG8_BAR;
    for (;;) {
        const bool has_next = S.next(ui + 1, nxt);
        const char* nA = has_next ? nxt.a : cA; const char* nB = has_next ? nxt.b : cB;
        for (int t = 0; t < nt; t += 2) {
            const bool last = (t == nt - 2);
            const char* a1 = cA + (size_t)(t + 1) * kstepA;
            const char* a2 = last ? nA : cA + (size_t)(t + 2) * kstepA; const char* b2 = last ? nB : cB + (size_t)(t + 2) * kstepB;
            const char* a3 = a2 + kstepA; const char* b3 = b2 + kstepB;
            PG8_LDB(B0, 0, 0); PG8_LDB(B1, 0, 1); PG8_SCHED; PG8_LDA(At, 0, 0); PG8_STAGE(PG8_SA(1, 1), a1 + hstepA, voffA);
            PG8_WAIT_V(8); PG8_WAIT_L(0); PG8_BAR; PG8_MMA(0, 0, At, B0); PG8_MMA(0, 1, At, B1); PG8_BAR; PG8_SCHED;
            PG8_LDA(At, 0, 1); PG8_STAGE(PG8_SB(0, 0), b2, voffB); PG8_STAGE(PG8_SB(0, 1), b2 + hstepB, voffB); PG8_STAGE(PG8_SA(0, 0), a2, voffA);
            PG8_WAIT_V(8); PG8_WAIT_L(0); PG8_BAR; PG8_MMA(1, 0, At, B0); PG8_MMA(1, 1, At, B1); PG8_BAR; PG8_SCHED;
            PG8_LDB(B0, 1, 0); PG8_LDB(B1, 1, 1); PG8_SCHED; PG8_LDA(At, 1, 0); PG8_STAGE(PG8_SA(0, 1), a2 + hstepA, voffA);
            PG8_WAIT_V(8); PG8_WAIT_L(0); PG8_BAR; PG8_MMA(0, 0, At, B0); PG8_MMA(0, 1, At, B1); PG8_BAR; PG8_SCHED;
            PG8_LDA(At, 1, 1); PG8_STAGE(PG8_SB(1, 0), b3, voffB); PG8_STAGE(PG8_SB(1, 1), b3 + hstepB, voffB); PG8_STAGE(PG8_SA(1, 0), a3, voffA);
            PG8_WAIT_V(8); PG8_WAIT_L(0); PG8_BAR; PG8_MMA(1, 0, At, B0); PG8_MMA(1, 1, At, B1); PG8_BAR; PG8_SCHED;
        }
        if constexpr (ALIGN_EPI) { if (wr == 0) PG8_BAR; }
        if constexpr (MODE != 0) asm volatile("s_nop 15\n\ts_nop 7" ::: "memory");
        E(acc, cur, wr, wc, fr, fq);
        if (!has_next) break;
#pragma unroll
        for (int a = 0; a < 2; ++a)
#pragma unroll
            for (int b = 0; b < 2; ++b)
#pragma unroll
                for (int m = 0; m < 4; ++m)
#pragma unroll
                    for (int n = 0; n < 2; ++n) acc[a][b][m][n] = (f32x4){0.f, 0.f, 0.f, 0.f};
        cur = nxt; cA = nA; cB = nB; ++ui;
        if constexpr (ALIGN_EPI) { if (wr == 1) PG8_BAR; }
    }
    PG8_WAIT_V(0);
    if constexpr (!ALIGN_EPI) { if (wr == 0) PG8_BAR; }
    PG8_BAR;
#undef PG8_SA
#undef PG8_SB
#undef PG8_STAGE
#undef PG8_LDA
#undef PG8_LDB
#undef PG8_MMA
#undef PG8_WAIT_V
#undef PG8_WAIT_L
#undef PG8_BAR
#undef PG8_SCHED
}
}

constexpr int NWAVES = 8;
constexpr int NPH = 19;
constexpr int N_LAUNCHES = MK_N_LAUNCHES;
static_assert(N_LAUNCHES == 1 || N_LAUNCHES == NPH, "MK_N_LAUNCHES must be 1 or 19");

constexpr size_t MiB = 1u << 20;
constexpr size_t WS_CTL = 0, CTL_ZERO_BYTES = 1 * MiB;
constexpr size_t WS_TAB = 1 * MiB;
constexpr size_t TAB_TE = 0, TAB_TW = 64 * 1024, TAB_CNT = 192 * 1024, TAB_SLOT = 256 * 1024, TAB_WSLOT = 384 * 1024, TAB_TILE = 640 * 1024, TAB_SA = 768 * 1024, TAB_SW = 832 * 1024;
constexpr size_t CTL_CMAX = 65536;
constexpr size_t WS_WQKV = 3 * MiB;
constexpr size_t WS_WO = WS_WQKV + (size_t)QKVD * D * 2;
constexpr size_t WS_WGU = WS_WO + (size_t)D * D * 2;
constexpr size_t WS_WD = WS_WGU + (size_t)2 * FF * D * 2;
constexpr size_t WS_WIN = WS_WD + (size_t)D * FF * 2;
constexpr size_t WS_WG = WS_WIN + (size_t)D * D * 2;
constexpr size_t WS_WOUT = WS_WG + (size_t)4 * 512 * 512 * 2;
constexpr size_t WS_WMGU = WS_WOUT + (size_t)D * D * 2;
constexpr size_t WS_WMD = WS_WMGU + (size_t)NE * 2 * FFE * D * 2;
constexpr size_t WS_H = WS_WMD + (size_t)NE * D * FFE * 2;
constexpr size_t WS_BIG = WS_H + (size_t)T * D * 2;
constexpr size_t BIG_BYTES = (size_t)SLOTS_MAX * FFE * 2;
static_assert((size_t)SLOTS_MAX * FFEP <= 288 * MiB && 288 * MiB + 64 * MiB <= BIG_BYTES, "ACTM + partials fit");
constexpr size_t WS_QKV = WS_BIG, WS_AO = WS_BIG + (size_t)T * QKVD * 2, WS_ACT = WS_AO + (size_t)T * D * 2;
constexpr size_t WS_U = WS_BIG, WS_DD = WS_U + (size_t)T * D * 2, WS_Y = WS_DD + (size_t)T * D * 2;
constexpr size_t WS_ACTM = WS_BIG;
constexpr size_t WS_PART = WS_BIG + 288 * MiB;
constexpr size_t WS_WGU8 = WS_BIG + 400 * MiB;
constexpr size_t WS_HS = WS_BIG + BIG_BYTES;
constexpr size_t WS_END = WS_HS + (size_t)SLOTS_MAX * D * 2;
static_assert(WS_ACT + (size_t)T * FF * 2 <= WS_BIG + BIG_BYTES && WS_Y + (size_t)T * D * 2 <= WS_BIG + BIG_BYTES, "overlays fit");
static_assert(WS_WQKV % 256 == 0 && WS_H % 256 == 0 && WS_BIG % 256 == 0 && WS_HS % 256 == 0, "alignment");

constexpr int TAIL_PM0 = 128;
__host__ __device__ __forceinline__ int tail_split(int R) { return R <= 2 ? 14 : (R <= 4 ? 7 : 4); }
constexpr int CW_TMO = 0;
constexpr int CW_BAR = 4096;

constexpr int RING_OFF = 0, RING_BYTES = 131072;
constexpr int LTAB_OFF = 135168;
constexpr int MISC_OFF = LTAB_OFF + 1024;
constexpr int LDS_BYTES = 147456;

#define RLX_AGENT __ATOMIC_RELAXED, __HIP_MEMORY_SCOPE_AGENT
#define LDS_WAIT() asm volatile("s_waitcnt lgkmcnt(0)" ::: "memory")
#define VM_WAIT() asm volatile("s_waitcnt vmcnt(0)" ::: "memory")

#define XB_TMO      128
#define XB_XCNT(j)  (256  + 64 * (j))
#define XB_XSUB(j)  (1280 + 64 * (j))
#define XB_XGEN(j)  (2304 + 64 * (j))
#define XB_TOP      3328
#define XB_TOPGEN   3392
#define XCD_BAR_WORDS 3456
#define XB_SPIN_CAP (1u << 18)
__device__ __forceinline__ unsigned xb_ld(unsigned* p)              { return __hip_atomic_load(p, __ATOMIC_RELAXED, __HIP_MEMORY_SCOPE_AGENT); }
__device__ __forceinline__ unsigned xb_add(unsigned* p, unsigned v) { return __hip_atomic_fetch_add(p, v, __ATOMIC_RELAXED, __HIP_MEMORY_SCOPE_AGENT); }
__device__ __forceinline__ unsigned xb_xcc_id() { return (unsigned)__builtin_amdgcn_s_getreg((3 << 11) | 20) & 0xFu; }
#define XB_SPIN(cond, bar) do { unsigned _sp = 0; while (cond) { __builtin_amdgcn_s_sleep(1); \
    if ((++_sp & 255u) == 0u) { if (xb_ld(&(bar)[XB_TMO])) break; if (_sp > XB_SPIN_CAP) { atomicAdd(&(bar)[XB_TMO], 1u); break; } } } } while (0)
struct XcdBarrier { unsigned* bar; unsigned x; volatile LAS unsigned* st; };
__device__ __forceinline__ XcdBarrier xcd_barrier_post(unsigned* bar, volatile LAS unsigned* st) {
    XcdBarrier b; b.bar = bar; b.x = xb_xcc_id(); b.st = st;
    if (threadIdx.x == 0) (void)xb_add(&bar[XB_XCNT(b.x)], 1u);
    return b;
}
__device__ __forceinline__ void xcd_barrier_complete(unsigned* bar, unsigned x, unsigned& nloc, unsigned& nx) {
    const unsigned G = gridDim.x * gridDim.y * gridDim.z;
    unsigned sum, cnt, mine, sp = 0u;
    for (;;) {
        sum = 0u; cnt = 0u; mine = 0u;
#pragma unroll
        for (unsigned j = 0; j < 16; ++j) { const unsigned c = xb_ld(&bar[XB_XCNT(j)]); sum += c; cnt += (c > 0u) ? 1u : 0u; mine = (j == x) ? c : mine; }
        if (sum == G) break;
        __builtin_amdgcn_s_sleep(1);
        if ((++sp & 255u) == 0u) { if (xb_ld(&bar[XB_TMO])) break; if (sp > XB_SPIN_CAP) { atomicAdd(&bar[XB_TMO], 1u); break; } }
    }
    nloc = mine > 0u ? mine : 1u; nx = cnt > 0u ? cnt : 1u;
}
__device__ __forceinline__ void xcd_barrier(const XcdBarrier& b) {
    asm volatile("s_waitcnt vmcnt(0)" ::: "memory");
    __syncthreads();
    if (threadIdx.x == 0) {
        unsigned* bar = b.bar;
        __builtin_amdgcn_s_waitcnt(0);
        unsigned nloc = b.st[0], nx = b.st[1];
        if (nloc == 0u) { xcd_barrier_complete(bar, b.x, nloc, nx); b.st[0] = nloc; b.st[1] = nx; }
        const unsigned old = xb_add(&bar[XB_XSUB(b.x)], 1u);
        const unsigned gen = old / nloc;
        if (old + 1u == (gen + 1u) * nloc) {
            __builtin_amdgcn_fence(__ATOMIC_RELEASE, "agent");
            asm volatile("s_waitcnt vmcnt(0)" ::: "memory");
            const unsigned og = xb_add(&bar[XB_TOP], 1u);
            const unsigned tg = og / nx;
            if (og + 1u == (tg + 1u) * nx) xb_add(&bar[XB_TOPGEN], 1u);
            else XB_SPIN(xb_ld(&bar[XB_TOPGEN]) == tg, bar);
            __builtin_amdgcn_fence(__ATOMIC_ACQUIRE, "agent");
            xb_add(&bar[XB_XGEN(b.x)], 1u);
            asm volatile("s_waitcnt vmcnt(0)" ::: "memory");
        } else {
            XB_SPIN(xb_ld(&bar[XB_XGEN(b.x)]) == gen, bar);
            __builtin_amdgcn_fence(__ATOMIC_ACQUIRE, "agent");
            asm volatile("s_waitcnt vmcnt(0)" ::: "memory");
        }
    }
    __syncthreads();
}

__device__ __forceinline__ float wave_sum(float v) {
#pragma unroll
    for (int o = 1; o < 64; o <<= 1) v += __shfl_xor(v, o);
    return v;
}
__device__ __forceinline__ int wave_sum_i(int v) {
#pragma unroll
    for (int o = 1; o < 64; o <<= 1) v += __shfl_xor(v, o);
    return v;
}

struct CvtDesc { const float* src; unsigned char* dst; int N; int ldd; int f8; int nkt, perm, drow0, kb0; unsigned* cmax; };
__device__ __forceinline__ void cvt_mk(CvtDesc& d, const float* W, int N, void* WT, int ldd_elems, int map, int f8, int item, int nkt = 0, int perm = 0, unsigned* cmax = nullptr) {
    const int nblk = N >> 6, kb = item / nblk, nb = item - kb * nblk, k0 = kb << 6, n0 = nb << 6;
    const int drow0 = (map == 0) ? n0 : (((n0 >> 7) << 8) + (n0 & 127) + (map == 2 ? 128 : 0)), esz = f8 ? 1 : 2;
    d.src = W + (size_t)k0 * N + n0; d.N = N; d.ldd = ldd_elems * esz; d.f8 = f8; d.nkt = nkt; d.perm = perm; d.drow0 = drow0; d.kb0 = k0 * esz; d.cmax = cmax;
    d.dst = nkt ? (unsigned char*)WT : (unsigned char*)WT + ((size_t)drow0 * ldd_elems + k0) * esz;
}
__device__ __forceinline__ unsigned char* cvt_dst(const CvtDesc& d, int n, int cbyte) {
    if (!d.nkt) return d.dst + (size_t)n * d.ldd + cbyte;
    int row = d.drow0 + n; if (d.perm) row = (row & ~31) + inv_perm32(row & 31);
    return d.dst + tiled_off(row, d.kb0 + cbyte, d.nkt);
}
__device__ __forceinline__ void cvt_load(const CvtDesc& d, f32x4 (&v)[16], int lane) {
    const float* src = d.src + (size_t)(lane >> 4) * d.N + 4 * (lane & 15);
#pragma unroll
    for (int i = 0; i < 16; ++i) v[i] = __builtin_nontemporal_load((const f32x4*)(src + (size_t)(4 * i) * d.N));
}
__device__ __forceinline__ void cvt_process(const CvtDesc& d, const f32x4 (&v)[16], LAS float* scr, int lane) {
    { const int r4 = lane >> 4, c4 = lane & 15;
#pragma unroll
      for (int i = 0; i < 16; ++i) { LAS float* p = scr + (4 * i + r4) * 65 + 4 * c4; p[0] = v[i].x; p[1] = v[i].y; p[2] = v[i].z; p[3] = v[i].w; } }
    LDS_WAIT(); asm volatile("" ::: "memory");
    const int c = lane & 7;
    if (d.f8) {
#pragma unroll
        for (int j = 0; j < 8; ++j) { const int n = (lane >> 3) + 8 * j; const LAS float* s = scr + (8 * c) * 65 + n;
            u32x2 o; o.x = pk4_fp8(s[0 * 65] * W8_SCALE, s[1 * 65] * W8_SCALE, s[2 * 65] * W8_SCALE, s[3 * 65] * W8_SCALE); o.y = pk4_fp8(s[4 * 65] * W8_SCALE, s[5 * 65] * W8_SCALE, s[6 * 65] * W8_SCALE, s[7 * 65] * W8_SCALE);
            *(u32x2*)cvt_dst(d, n, 8 * c) = o; }
    } else {
#pragma unroll
        for (int j = 0; j < 8; ++j) { const int n = (lane >> 3) + 8 * j; const LAS float* s = scr + (8 * c) * 65 + n;
            u32x4 o; o.x = pk2(s[0 * 65], s[1 * 65]); o.y = pk2(s[2 * 65], s[3 * 65]); o.z = pk2(s[4 * 65], s[5 * 65]); o.w = pk2(s[6 * 65], s[7 * 65]);
            *(u32x4*)cvt_dst(d, n, 16 * c) = o;
            if (d.cmax) {
                float mx = fmaxf(fmaxf(fmaxf(fabsf(s[0 * 65]), fabsf(s[1 * 65])), fmaxf(fabsf(s[2 * 65]), fabsf(s[3 * 65]))), fmaxf(fmaxf(fabsf(s[4 * 65]), fabsf(s[5 * 65])), fmaxf(fabsf(s[6 * 65]), fabsf(s[7 * 65]))));
                mx = fmaxf(mx, __shfl_xor(mx, 1)); mx = fmaxf(mx, __shfl_xor(mx, 2)); mx = fmaxf(mx, __shfl_xor(mx, 4));
                if (c == 0) atomicMax(d.cmax + d.drow0 + n, __float_as_uint(mx)); } }
    }
    LDS_WAIT(); asm volatile("" ::: "memory");
}


struct MoeCvtTile { const float* src; unsigned char* dst; int N; int kind; int n0; int k0; };
__device__ __forceinline__ void moe_cvt_decode(MoeCvtTile& t, int tile, const float* wg, const float* wu, const float* wd, unsigned char* Wmgu8, unsigned char* Wmd8) {
    constexpr int TPE = 448;
    const int mat = tile / (NE * TPE), r = tile - mat * (NE * TPE), e = r / TPE, q = r - e * TPE;
    if (mat < 2) { const int kb = q / 14, nb = q - kb * 14; t.src = (mat == 0 ? wg : wu) + (size_t)e * D * FFE + (size_t)(kb * 64) * FFE + nb * 512; t.N = FFE; t.kind = mat; t.n0 = nb * 512; t.k0 = kb * 64; t.dst = Wmgu8 + (size_t)e * 2 * FFE * D; }
    else { const int kb = q >> 2, nb = q & 3; t.src = wd + (size_t)e * FFE * D + (size_t)(kb * 64) * D + nb * 512; t.N = D; t.kind = 2; t.n0 = nb * 512; t.k0 = kb * 64; t.dst = Wmd8 + (size_t)e * D * FFE; }
}
__device__ __forceinline__ void moe_cvt_load(const MoeCvtTile& t, f32x4 (&v)[16], int tid) {
    const float* p = t.src + (size_t)(tid >> 7) * t.N + 4 * (tid & 127);
#pragma unroll
    for (int i = 0; i < 16; ++i) v[i] = __builtin_nontemporal_load((const f32x4*)(p + (size_t)(4 * i) * t.N));
}
__device__ __forceinline__ void moe_cvt_process(const MoeCvtTile& t, const f32x4 (&v)[16], LAS float* scr, int tid) {
    { LAS f32x4* w = (LAS f32x4*)(scr + (tid >> 7) * 512 + 4 * (tid & 127));
#pragma unroll
      for (int i = 0; i < 16; ++i) w[i * 512] = v[i]; }
    __syncthreads();
    const int n = t.n0 + tid;
    u32x4 o[4];
#pragma unroll
    for (int j = 0; j < 4; ++j) { const LAS float* s = scr + (16 * j) * 512 + tid;
        o[j].x = pk4_fp8(s[0 * 512] * W8_SCALE, s[1 * 512] * W8_SCALE, s[2 * 512] * W8_SCALE, s[3 * 512] * W8_SCALE); o[j].y = pk4_fp8(s[4 * 512] * W8_SCALE, s[5 * 512] * W8_SCALE, s[6 * 512] * W8_SCALE, s[7 * 512] * W8_SCALE);
        o[j].z = pk4_fp8(s[8 * 512] * W8_SCALE, s[9 * 512] * W8_SCALE, s[10 * 512] * W8_SCALE, s[11 * 512] * W8_SCALE); o[j].w = pk4_fp8(s[12 * 512] * W8_SCALE, s[13 * 512] * W8_SCALE, s[14 * 512] * W8_SCALE, s[15 * 512] * W8_SCALE); }
    if (t.kind < 2) { unsigned char* d = t.dst + (size_t)(((n >> 7) << 8) + (n & 127) + (t.kind == 1 ? 128 : 0)) * D + t.k0;
#pragma unroll
        for (int j = 0; j < 4; ++j) *(u32x4*)(d + 16 * j) = o[j]; }
    else { const int row = (n & ~31) + inv_perm32(n & 31);
#pragma unroll
        for (int j = 0; j < 4; ++j) *(u32x4*)(t.dst + tiled_off(row, t.k0 + 16 * j, FFE / 128)) = o[j]; }
    __syncthreads();
}

__device__ __forceinline__ void rms_load(f32x4 (&v)[8], const float* X, int m, int lane) { const f32x4* xr = (const f32x4*)(X + (size_t)m * D) + lane;
#pragma unroll
    for (int j = 0; j < 8; ++j) v[j] = xr[64 * j]; }
__device__ __forceinline__ float wave_max(float v) {
#pragma unroll
    for (int o = 1; o < 64; o <<= 1) v = fmaxf(v, __shfl_xor(v, o));
    return v;
}
__device__ __forceinline__ unsigned pk4_i8(float a, float b, float c, float d) {
    a = __builtin_amdgcn_fmed3f(a, -127.f, 127.f); b = __builtin_amdgcn_fmed3f(b, -127.f, 127.f); c = __builtin_amdgcn_fmed3f(c, -127.f, 127.f); d = __builtin_amdgcn_fmed3f(d, -127.f, 127.f);
    const unsigned ua = (unsigned)(int)(a + 128.f), ub = (unsigned)(int)(b + 128.f), uc = (unsigned)(int)(c + 128.f), ud = (unsigned)(int)(d + 128.f);
    return (ua | (ub << 8) | (uc << 16) | (ud << 24)) ^ 0x80808080u; }
__device__ __forceinline__ void rms_finish_i8(const f32x4 (&v)[8], const f32x4 (&g)[8], bf16_t* H, float* sA, int m, int lane) {
    float s = 0.f;
#pragma unroll
    for (int j = 0; j < 8; ++j) s += (v[j].x * v[j].x + v[j].y * v[j].y) + (v[j].z * v[j].z + v[j].w * v[j].w);
    const float rs = 1.0f / sqrtf(wave_sum(s) * (1.f / D) + EPS);
    f32x4 h[8]; float am = 0.f;
#pragma unroll
    for (int j = 0; j < 8; ++j) { h[j] = v[j] * rs * g[j]; am = fmaxf(am, fmaxf(fmaxf(fabsf(h[j].x), fabsf(h[j].y)), fmaxf(fabsf(h[j].z), fabsf(h[j].w)))); }
    am = fmaxf(wave_max(am), 1e-30f);
    const float inv = 127.0f / am;
    unsigned* o4 = (unsigned*)((unsigned char*)H + (size_t)m * D) + lane;
#pragma unroll
    for (int j = 0; j < 8; ++j) o4[64 * j] = pk4_i8(__builtin_rintf(h[j].x * inv), __builtin_rintf(h[j].y * inv), __builtin_rintf(h[j].z * inv), __builtin_rintf(h[j].w * inv));
    if (lane == 0) sA[m] = am * (1.0f / 127.0f);
}
__device__ __forceinline__ void rms_finish(const f32x4 (&v)[8], const f32x4 (&g)[8], bf16_t* H, int m, int lane) {
    float s = 0.f;
#pragma unroll
    for (int j = 0; j < 8; ++j) s += (v[j].x * v[j].x + v[j].y * v[j].y) + (v[j].z * v[j].z + v[j].w * v[j].w);
    const float rs = 1.0f / sqrtf(wave_sum(s) * (1.f / D) + EPS);
    u32x2* o8 = (u32x2*)(H + (size_t)m * D) + lane;
#pragma unroll
    for (int j = 0; j < 8; ++j) { u32x2 w; w.x = pk2(v[j].x * rs * g[j].x, v[j].y * rs * g[j].y); w.y = pk2(v[j].z * rs * g[j].z, v[j].w * rs * g[j].w); o8[64 * j] = w; }
}
template <bool I8 = false> __device__ __forceinline__ void rms_phase(const float* X, const float* gain, bf16_t* H, int gw, int NGW, int lane, float* sA = nullptr) {
    f32x4 g[8], va[8], vb[8];
#pragma unroll
    for (int j = 0; j < 8; ++j) g[j] = ((const f32x4*)gain + lane)[64 * j];
    int m = gw; if (m >= T) return;
    rms_load(va, X, m, lane);
    for (;;) {
        const int mn = m + NGW; if (mn < T) rms_load(vb, X, mn, lane);
        if constexpr (I8) rms_finish_i8(va, g, H, sA, m, lane); else rms_finish(va, g, H, m, lane);
        if (mn >= T) break;
        m = mn + NGW; if (m < T) rms_load(va, X, m, lane);
        if constexpr (I8) rms_finish_i8(vb, g, H, sA, mn, lane); else rms_finish(vb, g, H, mn, lane);
        if (m >= T) break;
    }
}

__device__ __forceinline__ unsigned off_b(unsigned row, unsigned ch) { return 256u * row + 16u * (ch ^ (((row & 3u) << 2) | ((row >> 2) & 3u))); }
__device__ __forceinline__ s16x4 tr_read(const LAS unsigned char* p) { return __builtin_bit_cast(s16x4, __builtin_amdgcn_ds_read_tr16_b64_v4i16((LAS s16x4*)p)); }

__device__ __forceinline__ void quant_rows_i8(const bf16_t* W, unsigned char* W8, const unsigned* cmax, float* sw, int rows, int gw, int NGW, int lane) {
    for (int n = gw; n < rows; n += NGW) {
        const float am = fmaxf(__uint_as_float(cmax[n]), 1e-30f), inv = 127.0f / am;
        const u32x4* src = (const u32x4*)(W + (size_t)n * D); u32x4* dst = (u32x4*)(W8 + (size_t)n * D) + lane;
        u32x4 wv[4];
#pragma unroll
        for (int k = 0; k < 4; ++k) wv[k] = src[2 * lane + (k & 1) + 128 * (k >> 1)];
#pragma unroll
        for (int k = 0; k < 4; k += 2) { u32x4 o; const u32x4 a = wv[k], b2 = wv[k + 1];
            o.x = pk4_i8(__builtin_rintf(bf_lo(a.x) * inv), __builtin_rintf(bf_hi(a.x) * inv), __builtin_rintf(bf_lo(a.y) * inv), __builtin_rintf(bf_hi(a.y) * inv));
            o.y = pk4_i8(__builtin_rintf(bf_lo(a.z) * inv), __builtin_rintf(bf_hi(a.z) * inv), __builtin_rintf(bf_lo(a.w) * inv), __builtin_rintf(bf_hi(a.w) * inv));
            o.z = pk4_i8(__builtin_rintf(bf_lo(b2.x) * inv), __builtin_rintf(bf_hi(b2.x) * inv), __builtin_rintf(bf_lo(b2.y) * inv), __builtin_rintf(bf_hi(b2.y) * inv));
            o.w = pk4_i8(__builtin_rintf(bf_lo(b2.z) * inv), __builtin_rintf(bf_hi(b2.z) * inv), __builtin_rintf(bf_lo(b2.w) * inv), __builtin_rintf(bf_hi(b2.w) * inv));
            dst[64 * (k >> 1)] = o; }
        if (lane == 0) sw[n] = am * (1.0f / 127.0f);
    }
}

struct Args { const float* in[21]; float* out; unsigned char* ws; int ph_lo, ph_hi; };

enum { I_X = 0, I_MIXN, I_FFNN, I_RELB, I_WQKV, I_QG, I_KG, I_SINK, I_WO, I_FG, I_FU, I_FD, I_PIN, I_PG, I_PSC, I_POUT, I_RW, I_RB, I_MG, I_MU, I_MD };

__global__ void __launch_bounds__(NWAVES * 64, 2) fwd_kernel(Args args) {
    extern __shared__ __attribute__((aligned(16))) unsigned char lds_raw[];
    LAS unsigned char* lds = (LAS unsigned char*)lds_raw;
    volatile LAS unsigned* MISC = (volatile LAS unsigned*)(lds + MISC_OFF);
    const int tid = threadIdx.x, lane = tid & 63, wave = __builtin_amdgcn_readfirstlane(tid >> 6);
    const int G = gridDim.x, bx = blockIdx.x;
    const int gw = bx * NWAVES + wave, NGW = G * NWAVES;
    unsigned char* ws = args.ws;
    gu32* ctl = (gu32*)(ws + WS_CTL);
    if (tid < 32) MISC[tid] = 0u;
    __syncthreads();
    XcdBarrier bar; bar.bar = (unsigned*)(ws + WS_CTL) + CW_BAR; bar.x = 0; bar.st = nullptr;
    if (N_LAUNCHES == 1) bar = xcd_barrier_post((unsigned*)(ws + WS_CTL) + CW_BAR, MISC + 8);
#define GRID_BAR() do { if (N_LAUNCHES == 1) xcd_barrier(bar); } while (0)
    const int lo = args.ph_lo, hi = args.ph_hi;
#define IN(k) (lo <= (k) && (k) < hi)
#define REP(k) for (int _rep = 0; _rep < (((PROBE_MASK >> (k)) & 1) ? 2 : 1); ++_rep)
#define BOTH(k) (IN(k) && IN((k) + 1))

    bf16_t* const Wqkv = (bf16_t*)(ws + WS_WQKV); bf16_t* const Wo = (bf16_t*)(ws + WS_WO); bf16_t* const Wgu = (bf16_t*)(ws + WS_WGU); bf16_t* const Wd = (bf16_t*)(ws + WS_WD);
    bf16_t* const Win = (bf16_t*)(ws + WS_WIN); bf16_t* const Wg = (bf16_t*)(ws + WS_WG); bf16_t* const Wout = (bf16_t*)(ws + WS_WOUT);
    bf16_t* const Wmgu = (bf16_t*)(ws + WS_WMGU); bf16_t* const Wmd = (bf16_t*)(ws + WS_WMD);
    bf16_t* const Hb = (bf16_t*)(ws + WS_H); bf16_t* const QKV = (bf16_t*)(ws + WS_QKV); bf16_t* const AO = (bf16_t*)(ws + WS_AO); bf16_t* const ACT = (bf16_t*)(ws + WS_ACT);
    bf16_t* const Ub = (bf16_t*)(ws + WS_U); bf16_t* const DDb = (bf16_t*)(ws + WS_DD); bf16_t* const Yb = (bf16_t*)(ws + WS_Y);
    bf16_t* const ACTM = (bf16_t*)(ws + WS_ACTM); bf16_t* const HS = (bf16_t*)(ws + WS_HS);
    int* const tab_te = (int*)(ws + WS_TAB + TAB_TE); float* const tab_tw = (float*)(ws + WS_TAB + TAB_TW); int* const tab_cnt = (int*)(ws + WS_TAB + TAB_CNT);
    int* const tab_slot = (int*)(ws + WS_TAB + TAB_SLOT); float* const tab_wslot = (float*)(ws + WS_TAB + TAB_WSLOT); int* const tab_tile = (int*)(ws + WS_TAB + TAB_TILE);
    float* const OUT = args.out;
    unsigned* const cmax_gu = (unsigned*)(ws + WS_CTL + CTL_CMAX); float* const tab_sa = (float*)(ws + WS_TAB + TAB_SA); float* const tab_sw = (float*)(ws + WS_TAB + TAB_SW);
    unsigned char* const Wgu8 = ws + WS_WGU8; unsigned char* const Wqkv8 = ws + WS_WGU8 + (size_t)2 * FF * D; unsigned char* const Win8 = Wqkv8 + (size_t)QKVD * D; bf16_t* const Wpt = (bf16_t*)(Win8 + (size_t)D * D); unsigned char* const Wpt8 = (unsigned char*)Wpt + (size_t)D * D * 2;

        LAS float* scr = (LAS float*)(lds + RING_OFF + wave * 16640);
        constexpr int I_1 = (D / 64) * (QKVD / 64), I_2 = (D / 64) * (D / 64), I_3 = (D / 64) * (FF / 64), I_7 = 0, I_M = (D / 64) * (FFE / 64);
        constexpr int E1 = I_1, E2 = E1 + I_2, E3 = E2 + I_3, E4 = E3 + I_3, E5 = E4 + I_3, E6 = E5 + I_2, E7 = E6 + I_7, E8 = E7 + I_2, E9 = E8 + NE * I_M, E10 = E9 + NE * I_M, E11 = E10 + NE * I_M;
#define CVT_DECODE(it_, d_) do { const int _it = (it_); \
            if (_it < E1) cvt_mk(d_, args.in[I_WQKV], QKVD, Wqkv, D, 0, 0, _it, 0, 0, cmax_gu + 2 * FF); \
            else if (_it < E2) cvt_mk(d_, args.in[I_WO], D, Wo, D, 0, 1, _it - E1); \
            else if (_it < E3) cvt_mk(d_, args.in[I_FG], FF, Wgu, D, 1, 0, _it - E2, 0, 0, cmax_gu); \
            else if (_it < E4) cvt_mk(d_, args.in[I_FU], FF, Wgu, D, 2, 0, _it - E3, 0, 0, cmax_gu); \
            else if (_it < E5) cvt_mk(d_, args.in[I_FD], D, Wd, FF, 0, 1, _it - E4, FF / 128, 0); \
            else if (_it < E6) cvt_mk(d_, args.in[I_PIN], D, Win, D, 0, 0, _it - E5, 0, 0, cmax_gu + 2 * FF + QKVD); \
            else if (_it < E7) { const int _r = _it - E6, _g = _r >> 6; cvt_mk(d_, args.in[I_PG] + (size_t)_g * 512 * 512, 512, Wg + (size_t)_g * 512 * 512, 512, 0, 0, _r & 63); } \
            else if (_it < E8) cvt_mk(d_, args.in[I_POUT], D, Wout, D, 0, 0, _it - E7); \
            else if (_it < E9) { const int _r = _it - E8, _e = _r / I_M; cvt_mk(d_, args.in[I_MG] + (size_t)_e * D * FFE, FFE, (unsigned char*)Wmgu + (size_t)_e * 2 * FFE * D, D, 1, 1, _r - _e * I_M); } \
            else if (_it < E10) { const int _r = _it - E9, _e = _r / I_M; cvt_mk(d_, args.in[I_MU] + (size_t)_e * D * FFE, FFE, (unsigned char*)Wmgu + (size_t)_e * 2 * FFE * D, D, 2, 1, _r - _e * I_M); } \
            else { const int _r = _it - E10, _e = _r / I_M; cvt_mk(d_, args.in[I_MD] + (size_t)_e * FFE * D, D, (unsigned char*)Wmd + (size_t)_e * D * FFE, FFE, 0, 1, _r - _e * I_M, FFE / 128, 1); } } while (0)
#define CVT_RUN(IT0, IT1) do { CvtDesc dA, dB; f32x4 vA[16], vB[16]; int it = (IT0) + gw; \
          if (it < (IT1)) { CVT_DECODE(it, dA); cvt_load(dA, vA, lane); } \
          while (it < (IT1)) { \
              int itn = it + NGW; \
              if (itn < (IT1)) { CVT_DECODE(itn, dB); cvt_load(dB, vB, lane); } \
              cvt_process(dA, vA, scr, lane); \
              it = itn; if (it >= (IT1)) break; \
              itn = it + NGW; \
              if (itn < (IT1)) { CVT_DECODE(itn, dA); cvt_load(dA, vA, lane); } \
              cvt_process(dB, vB, scr, lane); \
              it = itn; \
          } } while (0)
    if (IN(0)) { REP(0) {
        CVT_RUN(0, E8);
        for (int i8 = bx * (NWAVES * 64) + tid; i8 < 4 * 512 * 512 / 8; i8 += G * NWAVES * 64) {
            const int e0 = (i8 & 63) * 8, g_ = i8 >> 15; const float* wp = args.in[I_PG] + (size_t)i8 * 8; const float* sp = args.in[I_PSC] + g_ * 512 + e0;
            const f32x4 a = *(const f32x4*)wp, b2 = *(const f32x4*)(wp + 4), sa_ = *(const f32x4*)sp, sb_ = *(const f32x4*)(sp + 4);
            u32x4 o; o.x = pk2(a.x * sa_.x, a.y * sa_.y); o.y = pk2(a.z * sa_.z, a.w * sa_.w); o.z = pk2(b2.x * sb_.x, b2.y * sb_.y); o.w = pk2(b2.z * sb_.z, b2.w * sb_.w);
            *(u32x4*)(Wg + (size_t)i8 * 8) = o; }
        }
        if (BOTH(0)) GRID_BAR();
    }
    if (IN(1)) { REP(1) {
        { pg8::WprodSched S; S.init(Wout, Wg, G, bx);
          pg8::EpiBf16 E{Wpt, D, nullptr, cmax_gu + 2 * FF + QKVD + D};
          pg8::gemm_phase<pg8::EpiBf16, pg8::WprodSched>(lds + RING_OFF, pg8::Gemm{D, 512, 512 / 64}, S, E); }
        { LAS float* scrb = (LAS float*)(lds + RING_OFF); MoeCvtTile tA, tB; f32x4 vA[16], vB[16];
          constexpr int NTILES = 3 * NE * 448; int it = bx;
          if (it < NTILES) { moe_cvt_decode(tA, it, args.in[I_MG], args.in[I_MU], args.in[I_MD], (unsigned char*)Wmgu, (unsigned char*)Wmd); moe_cvt_load(tA, vA, tid); }
          while (it < NTILES) {
              int itn = it + G;
              if (itn < NTILES) { moe_cvt_decode(tB, itn, args.in[I_MG], args.in[I_MU], args.in[I_MD], (unsigned char*)Wmgu, (unsigned char*)Wmd); moe_cvt_load(tB, vB, tid); }
              moe_cvt_process(tA, vA, scrb, tid);
              it = itn; if (it >= NTILES) break;
              itn = it + G;
              if (itn < NTILES) { moe_cvt_decode(tA, itn, args.in[I_MG], args.in[I_MU], args.in[I_MD], (unsigned char*)Wmgu, (unsigned char*)Wmd); moe_cvt_load(tA, vA, tid); }
              moe_cvt_process(tB, vB, scrb, tid);
              it = itn;
          } }
        quant_rows_i8(Wgu, Wgu8, cmax_gu, tab_sw, 2 * FF, gw, NGW, lane);
        quant_rows_i8(Wqkv, Wqkv8, cmax_gu + 2 * FF, tab_sw + 2 * FF, QKVD, gw, NGW, lane);
        quant_rows_i8(Win, Win8, cmax_gu + 2 * FF + QKVD, tab_sw + 2 * FF + QKVD, D, gw, NGW, lane);
        if (G > 64) { if (bx >= 64) rms_phase<true>(args.in[I_X], args.in[I_MIXN], Hb, (bx - 64) * NWAVES + wave, (G - 64) * NWAVES, lane, tab_sa); }
        else rms_phase<true>(args.in[I_X], args.in[I_MIXN], Hb, gw, NGW, lane, tab_sa);
        }
        if (BOTH(1)) GRID_BAR();
    }
#undef CVT_RUN
#undef CVT_DECODE

    if (IN(2)) { REP(2) {
        pg8::DenseSched S; S.init(Hb, (const bf16_t*)Wqkv8, T, QKVD, D / 2, D / 2, G, bx);
        pg8::EpiBf16i8 E{QKV, QKVD, tab_sa, tab_sw + 2 * FF};
        pg8::gemm_phase<pg8::EpiBf16i8, pg8::DenseSched, 2>(lds + RING_OFF, pg8::Gemm{D / 2, D / 2, D / 128}, S, E);
        }
        if (BOTH(2)) GRID_BAR();
    }


    if (IN(4)) { REP(4) {
        LAS float* tab = (LAS float*)(lds + 65536);
        for (int i = tid; i < 16 * 384; i += NWAVES * 64) {
            const int h = i / 384, r = (i - h * 384) - 192; float v = 0.f;
            if (r >= -128 && r <= 128) { const int n = r < 0 ? -r : r; int large = 2 + (31 - __builtin_clz((unsigned)(n * n) | 1u)); large = large < 15 ? large : 15;
                const int bucket = (r > 0 ? 16 : 0) + (n < 8 ? n : large); v = args.in[I_RELB][bucket * NH + h] * LOG2E; }
            tab[i] = v;
        }
        __syncthreads();
        const int g = wave >> 1, qh = wave & 1, r = lane & 31, h = lane >> 5;
        const f32x4 kg0 = *(const f32x4*)(args.in[I_KG] + (tid & 15) * 8), kg1 = *(const f32x4*)(args.in[I_KG] + (tid & 15) * 8 + 4);
        const float qsc = 0.08838834764831845f * LOG2E;
        const unsigned xr = ((r & 3u) << 2) | ((r >> 2) & 3u);
        const int tq = (lane & 15) >> 2, tp = lane & 3, tblk = (lane >> 4) & 1;
        for (int it = bx; it < BATCH * NKV * (SEQ / 64); it += G) {
            const int b = it >> 9, kvh = (it >> 7) & 3, qb = it & 127;
            const int q0 = qb * 64, ks0 = q0 - 128;
            const int c_lo = ks0 < 0 ? ((-ks0) >> 6) : 0;
            int c_hi = (SEQ - 1 - ks0) >> 6; c_hi = c_hi > 4 ? 4 : c_hi;
            const int hq = kvh * 4 + g;
            const size_t tokbase = (size_t)b * SEQ;
            const int qpos = q0 + 32 * qh + r;
            u32x4 kr[2], vr[2];
#define ATT_LOAD(c) do { _Pragma("unroll") for (int _i = 0; _i < 2; ++_i) { const int _p = tid + 512 * _i, _key = _p >> 4, _ch = _p & 15; \
                const bf16_t* _kp = QKV + (tokbase + (ks0 + 64 * (c) + _key)) * QKVD + D + kvh * HD + _ch * 8; kr[_i] = *(const u32x4*)_kp; vr[_i] = *(const u32x4*)(_kp + NKV * HD); } } while (0)
#define ATT_STORE(buf) do { _Pragma("unroll") for (int _i = 0; _i < 2; ++_i) { const int _p = tid + 512 * _i, _key = _p >> 4, _ch = _p & 15; \
                const unsigned _o = (unsigned)(buf) * 32768u + (unsigned)(_key >> 5) * 8192u + off_b((unsigned)(_key & 31), (unsigned)_ch); \
                const u32x4 _w = kr[_i]; float _ss = (bf_lo(_w.x) * bf_lo(_w.x) + bf_hi(_w.x) * bf_hi(_w.x)) + (bf_lo(_w.y) * bf_lo(_w.y) + bf_hi(_w.y) * bf_hi(_w.y)) + (bf_lo(_w.z) * bf_lo(_w.z) + bf_hi(_w.z) * bf_hi(_w.z)) + (bf_lo(_w.w) * bf_lo(_w.w) + bf_hi(_w.w) * bf_hi(_w.w)); \
                _ss += __shfl_xor(_ss, 1); _ss += __shfl_xor(_ss, 2); _ss += __shfl_xor(_ss, 4); _ss += __shfl_xor(_ss, 8);            \
                const float _rs = 1.0f / sqrtf(_ss * (1.f / HD) + EPS); const f32x4 _g0 = kg0 * _rs, _g1 = kg1 * _rs; \
                u32x4 _kn; _kn.x = pk2(bf_lo(_w.x) * _g0.x, bf_hi(_w.x) * _g0.y); _kn.y = pk2(bf_lo(_w.y) * _g0.z, bf_hi(_w.y) * _g0.w); _kn.z = pk2(bf_lo(_w.z) * _g1.x, bf_hi(_w.z) * _g1.y); _kn.w = pk2(bf_lo(_w.w) * _g1.z, bf_hi(_w.w) * _g1.w); \
                *(LAS u32x4*)(lds + _o) = _kn; *(LAS u32x4*)(lds + 16384u + _o) = vr[_i]; } } while (0)
            ATT_LOAD(c_lo);
            bf16x8 qf[8];
            { const bf16_t* qp = QKV + (tokbase + qpos) * QKVD + hq * HD + 8 * h;
#pragma unroll
              for (int s = 0; s < 8; ++s) qf[s] = *(const bf16x8*)(qp + 16 * s);
              float ss = 0.f;
#pragma unroll
              for (int s = 0; s < 8; ++s) { const u32x4 w = __builtin_bit_cast(u32x4, qf[s]);
                  ss += (bf_lo(w.x) * bf_lo(w.x) + bf_hi(w.x) * bf_hi(w.x)) + (bf_lo(w.y) * bf_lo(w.y) + bf_hi(w.y) * bf_hi(w.y)) + (bf_lo(w.z) * bf_lo(w.z) + bf_hi(w.z) * bf_hi(w.z)) + (bf_lo(w.w) * bf_lo(w.w) + bf_hi(w.w) * bf_hi(w.w)); }
              ss += __shfl_xor(ss, 32);
              const float rsq = qsc / sqrtf(ss * (1.f / HD) + EPS);
              const float* qgp = args.in[I_QG] + 8 * h;
#pragma unroll
              for (int s = 0; s < 8; ++s) { const u32x4 w = __builtin_bit_cast(u32x4, qf[s]); const f32x4 ga = *(const f32x4*)(qgp + 16 * s) * rsq, gb = *(const f32x4*)(qgp + 16 * s + 4) * rsq;
                  u32x4 o; o.x = pk2(bf_lo(w.x) * ga.x, bf_hi(w.x) * ga.y); o.y = pk2(bf_lo(w.y) * ga.z, bf_hi(w.y) * ga.w); o.z = pk2(bf_lo(w.z) * gb.x, bf_hi(w.z) * gb.y); o.w = pk2(bf_lo(w.w) * gb.z, bf_hi(w.w) * gb.w);
                  qf[s] = __builtin_bit_cast(bf16x8, o); } }
            f32x16 O[4];
#pragma unroll
            for (int c = 0; c < 4; ++c)
#pragma unroll
                for (int i = 0; i < 16; ++i) O[c][i] = 0.f;
            float m_run = args.in[I_SINK][hq] * LOG2E, l_run = (h == 0) ? 1.0f : 0.0f;
            ATT_STORE(0);
            __syncthreads();
            for (int c = c_lo; c <= c_hi; ++c) {
                const int cur = (c - c_lo) & 1;
                if (c < c_hi) ATT_LOAD(c + 1);
                const LAS unsigned char* kb = lds + (unsigned)cur * 32768u; const LAS unsigned char* vb = kb + 16384;
#pragma unroll
                for (int kt = 0; kt < 2; ++kt) {
                    const int kspan0 = 64 * c + 32 * kt, qs = 128 + 32 * qh;
                    if (kspan0 + 31 < qs - 128 || kspan0 > qs + 31 + 128) continue;
                    f32x16 sacc;
#pragma unroll
                    for (int i = 0; i < 16; ++i) sacc[i] = 0.f;
#pragma unroll
                    for (int s = 0; s < 8; ++s) { const bf16x8 kf = *(const LAS bf16x8*)(kb + kt * 8192 + 256u * r + 16u * ((unsigned)(2 * s + h) ^ xr));
                        sacc = __builtin_amdgcn_mfma_f32_32x32x16_bf16(kf, qf[s], sacc, 0, 0, 0); }
                    const int ib = kspan0 + 4 * h - (qs + r) + 192;
                    const LAS float* tb = tab + hq * 384 + ib;
                    float mx = -3.0e38f;
#pragma unroll
                    for (int i = 0; i < 16; ++i) { const int d = (i & 3) + 8 * (i >> 2); const int rel = ib + d - 192; const float bv = tb[d];
                        const float sv = (rel >= -128 && rel <= 128) ? sacc[i] + bv : -1.0e30f; sacc[i] = sv; mx = fmaxf(mx, sv); }
                    mx = fmaxf(mx, __shfl_xor(mx, 32));
                    const float m_new = fmaxf(m_run, mx);
                    if (__any(m_new > m_run)) {
                        const float alpha = __builtin_amdgcn_exp2f(m_run - m_new); m_run = m_new; l_run *= alpha;
#pragma unroll
                        for (int cc = 0; cc < 4; ++cc)
#pragma unroll
                            for (int i = 0; i < 16; ++i) O[cc][i] *= alpha; }
                    float ps = 0.f;
#pragma unroll
                    for (int i = 0; i < 16; ++i) { const float p = __builtin_amdgcn_exp2f(sacc[i] - m_run); sacc[i] = p; ps += p; }
                    l_run += ps;
                    bf16x8 pf[2];
#pragma unroll
                    for (int s2 = 0; s2 < 2; ++s2) { u32x4 w; w.x = pk2(sacc[8 * s2 + 0], sacc[8 * s2 + 1]); w.y = pk2(sacc[8 * s2 + 2], sacc[8 * s2 + 3]); w.z = pk2(sacc[8 * s2 + 4], sacc[8 * s2 + 5]); w.w = pk2(sacc[8 * s2 + 6], sacc[8 * s2 + 7]);
                        pf[s2] = __builtin_bit_cast(bf16x8, w); }
#pragma unroll
                    for (int cc = 0; cc < 4; ++cc)
#pragma unroll
                        for (int s2 = 0; s2 < 2; ++s2) {
                            const unsigned row0 = 16u * s2 + 4u * h + tq, ch = 4u * cc + 2u * tblk + (tp >> 1);
                            const s16x4 lo4 = tr_read(vb + kt * 8192 + off_b(row0, ch) + 8u * (tp & 1));
                            const s16x4 hi4 = tr_read(vb + kt * 8192 + off_b(row0 + 8u, ch) + 8u * (tp & 1));
                            const bf16x8 vf = __builtin_shufflevector(lo4, hi4, 0, 1, 2, 3, 4, 5, 6, 7);
                            O[cc] = __builtin_amdgcn_mfma_f32_32x32x16_bf16(vf, pf[s2], O[cc], 0, 0, 0);
                        }
                }
                if (c < c_hi) ATT_STORE(cur ^ 1);
                __syncthreads();
            }
#undef ATT_LOAD
#undef ATT_STORE
            const float linv = 1.0f / (l_run + __shfl_xor(l_run, 32));
            unsigned char* op = (unsigned char*)AO + (tokbase + qpos) * D + hq * HD + 4 * h;
#pragma unroll
            for (int cc = 0; cc < 4; ++cc)
#pragma unroll
                for (int ig = 0; ig < 4; ++ig) *(unsigned*)(op + 32 * cc + 8 * ig) = pk4_fp8(O[cc][4 * ig + 0] * linv, O[cc][4 * ig + 1] * linv, O[cc][4 * ig + 2] * linv, O[cc][4 * ig + 3] * linv);
        }
        }
        if (BOTH(4)) GRID_BAR();
    }

    if (IN(5)) { REP(5) {
        pg8::DenseSched S; S.init(AO, Wo, T, D, D / 2, D / 2, G, bx);
        pg8::EpiRes E{args.in[I_X], OUT, D, W8_INV};
        pg8::gemm_phase<pg8::EpiRes, pg8::DenseSched, 1>(lds + RING_OFF, pg8::Gemm{D / 2, D / 2, D / 128}, S, E);
        }
        if (BOTH(5)) GRID_BAR();
    }
    if (IN(6)) { REP(6) {
        rms_phase<true>(OUT, args.in[I_FFNN], Hb, gw, NGW, lane, tab_sa);
        quant_rows_i8(Wpt, Wpt8, cmax_gu + 2 * FF + QKVD + D, tab_sw + 2 * FF + QKVD + D, D, gw, NGW, lane);
        }
        if (BOTH(6)) GRID_BAR();
    }
    if (IN(7)) { REP(7) {
        pg8::DenseSched S; S.init(Hb, (const bf16_t*)Wgu8, T, 2 * FF, D / 2, D / 2, G, bx);
        pg8::EpiSwiGLUi8 E{ACT, FF, FF / 128, tab_sa, tab_sw, 1};
        pg8::gemm_phase<pg8::EpiSwiGLUi8, pg8::DenseSched, 2>(lds + RING_OFF, pg8::Gemm{D / 2, D / 2, D / 128}, S, E);
        }
        if (BOTH(7)) GRID_BAR();
    }
    if (IN(8)) { REP(8) {
        pg8::DenseSched S; S.init(ACT, Wd, T, D, FF / 2, FF / 2, G, bx);
        pg8::EpiRes E{OUT, OUT, D, W8_INV};
        pg8::gemm_phase<pg8::EpiRes, pg8::DenseSched, 1>(lds + RING_OFF, pg8::Gemm{FF / 2, FF / 2, FF / 128, FF / 128, FF / 128}, S, E);
        }
        if (BOTH(8)) GRID_BAR();
    }
    if (IN(9)) { REP(9) {
        rms_phase<true>(OUT, args.in[I_MIXN] + D, Hb, gw, NGW, lane, tab_sa);
        }
        if (BOTH(9)) GRID_BAR();
    }
    if (IN(10)) { REP(10) {
        pg8::DenseSched S; S.init(Hb, (const bf16_t*)Win8, T, D, D / 2, D / 2, G, bx);
        pg8::EpiBf16i8 E{Ub, D, tab_sa, tab_sw + 2 * FF + QKVD};
        pg8::gemm_phase<pg8::EpiBf16i8, pg8::DenseSched, 2>(lds + RING_OFF, pg8::Gemm{D / 2, D / 2, D / 128}, S, E);
        }
        if (BOTH(10)) GRID_BAR();
    }
    if (IN(11)) { REP(11) {
        LAS float* rmx = (LAS float*)(lds + RING_OFF);
        for (int idx = bx * (NWAVES * 64) + tid; idx < (T / 16) * (D / 8); idx += G * NWAVES * 64) {
            const int rb = idx >> 8, c8 = idx & 255, grp = c8 >> 6, h = 1 << grp, rbl = tid >> 8;
            const int t0 = rb * 16, b = t0 >> 13, tt0 = t0 & (SEQ - 1);
            const bf16_t* up = Ub + ((size_t)b * SEQ) * D + c8 * 8;
            float a[8];
#pragma unroll
            for (int i = 0; i < 8; ++i) a[i] = 0.f;
            { int lo_ = tt0 - h; lo_ = lo_ < 0 ? 0 : lo_; int hi_ = tt0 + h; hi_ = hi_ > SEQ ? SEQ : hi_;
              for (int j = lo_; j < hi_; ++j) { const u32x4 w = *(const u32x4*)(up + (size_t)j * D);
                  a[0] += bf_lo(w.x); a[1] += bf_hi(w.x); a[2] += bf_lo(w.y); a[3] += bf_hi(w.y); a[4] += bf_lo(w.z); a[5] += bf_hi(w.z); a[6] += bf_lo(w.w); a[7] += bf_hi(w.w); } }
            u32x4 dres[16];
#pragma unroll
            for (int sb = 0; sb < 2; ++sb) {
                const int tb = tt0 + 8 * sb;
                u32x4 wc[8], wa[8], wsb[8];
#pragma unroll
                for (int j = 0; j < 8; ++j) { const int tt = tb + j; int ra = tt + h; ra = ra > SEQ - 1 ? SEQ - 1 : ra; int rs_ = tt - h; rs_ = rs_ < 0 ? 0 : rs_;
                    wc[j] = *(const u32x4*)(up + (size_t)tt * D); wa[j] = *(const u32x4*)(up + (size_t)ra * D); wsb[j] = *(const u32x4*)(up + (size_t)rs_ * D); }
#pragma unroll
                for (int j = 0; j < 8; ++j) { const int tt = tb + j; int lo_ = tt - h; lo_ = lo_ < 0 ? 0 : lo_; int hi_ = tt + h; hi_ = hi_ > SEQ ? SEQ : hi_;
                    const float inv = 1.0f / (float)(hi_ - lo_); const u32x4 w = wc[j];
                    const float d0 = a[0] * inv - bf_lo(w.x), d1 = a[1] * inv - bf_hi(w.x), d2 = a[2] * inv - bf_lo(w.y), d3 = a[3] * inv - bf_hi(w.y), d4 = a[4] * inv - bf_lo(w.z), d5 = a[5] * inv - bf_hi(w.z), d6 = a[6] * inv - bf_lo(w.w), d7 = a[7] * inv - bf_hi(w.w);
                    u32x4 o; o.x = pk2(d0, d1); o.y = pk2(d2, d3); o.z = pk2(d4, d5); o.w = pk2(d6, d7); dres[8 * sb + j] = o;
                    const float mxr = wave_max(fmaxf(fmaxf(fmaxf(fabsf(d0), fabsf(d1)), fmaxf(fabsf(d2), fabsf(d3))), fmaxf(fmaxf(fabsf(d4), fabsf(d5)), fmaxf(fabsf(d6), fabsf(d7)))));
                    if (lane == 0) rmx[(rbl * 16 + 8 * sb + j) * 4 + grp] = mxr;
                    const float ma = (tt + h < SEQ) ? 1.f : 0.f, ms = (tt - h >= 0) ? 1.f : 0.f; const u32x4 p = wa[j], q = wsb[j];
                    a[0] += ma * bf_lo(p.x) - ms * bf_lo(q.x); a[1] += ma * bf_hi(p.x) - ms * bf_hi(q.x); a[2] += ma * bf_lo(p.y) - ms * bf_lo(q.y); a[3] += ma * bf_hi(p.y) - ms * bf_hi(q.y);
                    a[4] += ma * bf_lo(p.z) - ms * bf_lo(q.z); a[5] += ma * bf_hi(p.z) - ms * bf_hi(q.z); a[6] += ma * bf_lo(p.w) - ms * bf_lo(q.w); a[7] += ma * bf_hi(p.w) - ms * bf_hi(q.w); }
                asm volatile("" ::: "memory");
            }
            __syncthreads();
            unsigned char* dp8 = (unsigned char*)DDb + ((size_t)b * SEQ + tt0) * D + c8 * 8;
#pragma unroll
            for (int j = 0; j < 16; ++j) { const f32x4 m4 = *(const LAS f32x4*)(rmx + (rbl * 16 + j) * 4); const float am = fmaxf(fmaxf(fmaxf(m4.x, m4.y), fmaxf(m4.z, m4.w)), 1e-30f), inv = 127.0f / am;
                const u32x4 w = dres[j]; u32x2 o;
                o.x = pk4_i8(__builtin_rintf(bf_lo(w.x) * inv), __builtin_rintf(bf_hi(w.x) * inv), __builtin_rintf(bf_lo(w.y) * inv), __builtin_rintf(bf_hi(w.y) * inv));
                o.y = pk4_i8(__builtin_rintf(bf_lo(w.z) * inv), __builtin_rintf(bf_hi(w.z) * inv), __builtin_rintf(bf_lo(w.w) * inv), __builtin_rintf(bf_hi(w.w) * inv));
                *(u32x2*)(dp8 + (size_t)j * D) = o;
                if (c8 == 0) tab_sa[t0 + j] = am * (1.0f / 127.0f); }
            __syncthreads();
        }
        }
        if (BOTH(11)) GRID_BAR();
    }
    if (IN(13)) { REP(13) {
        pg8::DenseSched S; S.init(DDb, (const bf16_t*)Wpt8, T, D, D / 2, D / 2, G, bx);
        pg8::EpiResI8 E{OUT, OUT, D, tab_sa, tab_sw + 2 * FF + QKVD + D};
        pg8::gemm_phase<pg8::EpiResI8, pg8::DenseSched, 2>(lds + RING_OFF, pg8::Gemm{D / 2, D / 2, D / 128}, S, E);
        }
        if (BOTH(13)) GRID_BAR();
    }
    if (IN(14)) { REP(14) {
        LAS float* rwl = (LAS float*)(lds + RING_OFF);
        LAS int* lcnt = (LAS int*)(lds + RING_OFF + 65536);
        const float* rw = args.in[I_RW]; const float* rb = args.in[I_RB];
        for (int rr = tid; rr < D; rr += NWAVES * 64) { const f32x4 a = *(const f32x4*)(rw + rr * 8), b2 = *(const f32x4*)(rw + rr * 8 + 4);
            rwl[0 * D + rr] = a.x; rwl[1 * D + rr] = a.y; rwl[2 * D + rr] = a.z; rwl[3 * D + rr] = a.w; rwl[4 * D + rr] = b2.x; rwl[5 * D + rr] = b2.y; rwl[6 * D + rr] = b2.z; rwl[7 * D + rr] = b2.w; }
        if (tid < 8) lcnt[tid] = 0;
        __syncthreads();
        const float* gain = args.in[I_FFNN] + D;
        if (G == 256) {
            f32x4 gg[8], va[8], vb[8];
#pragma unroll
            for (int j = 0; j < 8; ++j) gg[j] = ((const f32x4*)gain + lane)[64 * j];
#define P13_ROW(v, t_) do { const int t = (t_); float s = 0.f; \
                _Pragma("unroll") for (int j = 0; j < 8; ++j) s += (v[j].x * v[j].x + v[j].y * v[j].y) + (v[j].z * v[j].z + v[j].w * v[j].w); \
                const float rs = 1.0f / sqrtf(wave_sum(s) * (1.f / D) + EPS); \
                unsigned* o4 = (unsigned*)((unsigned char*)Hb + (size_t)t * D) + lane;        \
                _Pragma("unroll") for (int j = 0; j < 8; ++j) { v[j] = v[j] * rs * gg[j]; o4[64 * j] = pk4_fp8(v[j].x, v[j].y, v[j].z, v[j].w); } \
                float lg[8]; \
                _Pragma("unroll") for (int e = 0; e < 8; ++e) { float a = 0.f; \
                    _Pragma("unroll") for (int j = 0; j < 8; ++j) { const f32x4 w4 = *(const LAS f32x4*)(rwl + e * D + 4 * (lane + 64 * j)); a += (v[j].x * w4.x + v[j].y * w4.y) + (v[j].z * w4.z + v[j].w * w4.w); } \
                    lg[e] = wave_sum(a) + rb[e]; } \
                int e0 = 0; float v0 = lg[0]; \
                _Pragma("unroll") for (int e = 1; e < 8; ++e) if (lg[e] > v0) { v0 = lg[e]; e0 = e; } \
                int e1 = -1; float v1 = -3.0e38f; \
                _Pragma("unroll") for (int e = 0; e < 8; ++e) if (e != e0 && lg[e] > v1) { v1 = lg[e]; e1 = e; } \
                const float w0 = 1.0f / (1.0f + __expf(v1 - v0)), w1 = 1.0f - w0; \
                if (lane == 0) { tab_te[t] = e0 | (e1 << 8); tab_tw[2 * t] = w0; tab_tw[2 * t + 1] = w1; __hip_atomic_fetch_add(&lcnt[e0], 1, __ATOMIC_RELAXED, __HIP_MEMORY_SCOPE_WORKGROUP); __hip_atomic_fetch_add(&lcnt[e1], 1, __ATOMIC_RELAXED, __HIP_MEMORY_SCOPE_WORKGROUP); } } while (0)
            const int tw0 = 64 * bx + 8 * wave;
            rms_load(va, OUT, tw0, lane);
            for (int i = 0; i < 8; i += 2) {
                rms_load(vb, OUT, tw0 + i + 1, lane);
                P13_ROW(va, tw0 + i);
                if (i + 2 < 8) rms_load(va, OUT, tw0 + i + 2, lane);
                P13_ROW(vb, tw0 + i + 1);
            }
#undef P13_ROW
        }
        __syncthreads();
        if (tid < 8) tab_cnt[bx * 8 + tid] = lcnt[tid];
        }
        if (BOTH(14)) GRID_BAR();
    }
    if (IN(15)) { REP(15) {
        LAS int* arr = (LAS int*)(lds + RING_OFF);
        LAS int* ltot = arr + 2048; LAS int* lpre = ltot + 8; LAS int* lseg = lpre + 8; LAS int* lslot = lseg + 16;
        if (G == 256) {
            if (tid < 256) {
#pragma unroll
                for (int e = 0; e < 8; ++e) arr[e * 256 + tid] = tab_cnt[tid * 8 + e];
            }
            __syncthreads();
            { const int e = wave; int tot = 0, pre = 0;
#pragma unroll
              for (int k = 0; k < 4; ++k) { const int idx = lane * 4 + k; const int v = arr[e * 256 + idx]; tot += v; pre += (idx < bx) ? v : 0; }
              tot = wave_sum_i(tot); pre = wave_sum_i(pre);
              if (lane == 0) { ltot[e] = tot; lpre[e] = pre; } }
            __syncthreads();
            if (tid == 0) { int s = 0; for (int e = 0; e < 8; ++e) { lseg[e] = s; s += ((ltot[e] + 255) >> 8) << 8; } lseg[8] = s; }
            __syncthreads();
            if (bx == 0 && tid < 160) { const int slot = tid * 256; int e = 0;
#pragma unroll
                for (int k = 0; k < 8; ++k) if (slot >= lseg[k] && slot < lseg[k + 1]) e = k;
                tab_tile[tid] = e; if (tid == 0) tab_tile[255] = lseg[8] >> 8; }
            if (wave == 0) {
                const int t = 64 * bx + lane; const int pk = tab_te[t]; const int e0 = pk & 255, e1 = pk >> 8; int s0 = 0, s1 = 0;
                const unsigned long long lt = (1ull << lane) - 1ull;
#pragma unroll
                for (int e = 0; e < 8; ++e) { const int base = lseg[e] + lpre[e]; const unsigned long long m0 = __ballot(e0 == e), m1 = __ballot(e1 == e);
                    const int r0 = __popcll(m0 & lt), r1 = __popcll(m0) + __popcll(m1 & lt);
                    if (e0 == e) s0 = base + r0; if (e1 == e) s1 = base + r1; }
                tab_slot[2 * t] = s0; tab_slot[2 * t + 1] = s1; tab_wslot[s0] = tab_tw[2 * t]; tab_wslot[s1] = tab_tw[2 * t + 1];
                lslot[2 * lane] = s0; lslot[2 * lane + 1] = s1;
            }
            __syncthreads();
            for (int i = 0; i < 8; ++i) { const int tl = 8 * wave + i, t = 64 * bx + tl; const int s0 = lslot[2 * tl], s1 = lslot[2 * tl + 1];
                const u32x4* src = (const u32x4*)((unsigned char*)Hb + (size_t)t * D) + lane; u32x4* d0 = (u32x4*)((unsigned char*)HS + (size_t)s0 * D) + lane; u32x4* d1 = (u32x4*)((unsigned char*)HS + (size_t)s1 * D) + lane;
#pragma unroll
                for (int k = 0; k < 2; ++k) { const u32x4 w = src[64 * k]; d0[64 * k] = w; d1[64 * k] = w; } }
        }
        }
        if (BOTH(15)) GRID_BAR();
    }
    if (IN(16)) { REP(16) {
        LAS int* lt = (LAS int*)(lds + LTAB_OFF);
        if (tid < 256) lt[tid] = tab_tile[tid];
        __syncthreads();
        int nM = __builtin_amdgcn_readfirstlane(lt[255]); nM = nM < 0 ? 0 : (nM > SLOTS_MAX / 256 ? SLOTS_MAX / 256 : nM);
        pg8::MoeSched S; S.init(HS, Wmgu, nM, 2 * FFE, D / 2, D / 2, lt, G, bx);
        pg8::EpiSwiGLU8 E{(unsigned char*)ACTM, FFE, W8_INV, FFE / 128};
        pg8::gemm_phase<pg8::EpiSwiGLU8, pg8::MoeSched, true>(lds + RING_OFF, pg8::Gemm{D / 2, D / 2, D / 128}, S, E);
        }
        if (BOTH(16)) GRID_BAR();
    }
    if (IN(17)) { REP(17) {
        LAS int* lt = (LAS int*)(lds + LTAB_OFF);
        if (tid < 256) lt[tid] = tab_tile[tid];
        __syncthreads();
        int nM = __builtin_amdgcn_readfirstlane(lt[255]); nM = nM < 0 ? 0 : (nM > SLOTS_MAX / 256 ? SLOTS_MAX / 256 : nM);
        const int nMain = nM < TAIL_PM0 ? nM : TAIL_PM0, R = nM - nMain;
        { pg8::MoeSched S; S.init(ACTM, Wmd, nMain, D, FFE / 2, FFE / 2, lt, G, bx);
          pg8::EpiRowScaleBf16 E{HS, D, tab_wslot, W8_INV};
          pg8::gemm_phase<pg8::EpiRowScaleBf16, pg8::MoeSched, true>(lds + RING_OFF, pg8::Gemm{FFE / 2, FFE / 2, FFE / 128, FFE / 128, FFE / 128}, S, E); }
        if (R > 0) { const int Sk = tail_split(R);
          pg8::MoeTailSched S; S.init(ACTM, Wmd, TAIL_PM0, R, Sk, D, FFE / 2, FFE / 2, lt, G, bx);
          pg8::EpiPartF32 E{(float*)(ws + WS_PART), tab_wslot, W8_INV};
          pg8::gemm_phase<pg8::EpiPartF32, pg8::MoeTailSched, true>(lds + RING_OFF, pg8::Gemm{FFE / 2, FFE / 2, (FFE / 128) / Sk, FFE / 128, FFE / 128}, S, E); }
        }
        if (BOTH(17)) GRID_BAR();
    }
    if (IN(18)) {
        const bool bad = (N_LAUNCHES == 1) && (__hip_atomic_load((unsigned*)(ws + WS_CTL) + CW_BAR + XB_TMO, RLX_AGENT) != 0u);
#define P17_LOAD(ya, yb, ov, t_, sa, sb) do { const int _t = (t_); const int _s0 = tab_slot[2 * _t], _s1 = tab_slot[2 * _t + 1]; sa = _s0; sb = _s1; \
            const f32x4* _op = (const f32x4*)(OUT + (size_t)_t * D) + 2 * lane; const u32x4* _y0 = (const u32x4*)(HS + (size_t)_s0 * D) + lane; const u32x4* _y1 = (const u32x4*)(HS + (size_t)_s1 * D) + lane; \
            _Pragma("unroll") for (int k = 0; k < 4; ++k) { ya[k] = _y0[64 * k]; yb[k] = _y1[64 * k]; ov[2 * k] = _op[128 * k]; ov[2 * k + 1] = _op[128 * k + 1]; } } while (0)
#define P17_TAIL(yv, sl) do { if ((sl) >= TAIL_PM0 * 256) { const int _ut0 = (((sl) >> 8) - TAIL_PM0) * 8, _r = (sl) & 255; \
            _Pragma("unroll") for (int k = 0; k < 4; ++k) { const int _col = 8 * lane + 512 * k; const float* _pp = PART + ((size_t)(_ut0 + (_col >> 8)) * Sk) * 65536 + _r * 256 + (_col & 255); \
                f32x4 _a0 = {0.f, 0.f, 0.f, 0.f}, _a1 = {0.f, 0.f, 0.f, 0.f}; for (int _kp = 0; _kp < Sk; ++_kp) { _a0 += *(const f32x4*)(_pp + (size_t)_kp * 65536); _a1 += *(const f32x4*)(_pp + (size_t)_kp * 65536 + 4); } \
                u32x4 _w; _w.x = pk2(_a0.x, _a0.y); _w.y = pk2(_a0.z, _a0.w); _w.z = pk2(_a1.x, _a1.y); _w.w = pk2(_a1.z, _a1.w); yv[k] = _w; } } } while (0)
#define P17_FIN(ya, yb, ov, t_, sa, sb) do { f32x4* _op = (f32x4*)(OUT + (size_t)(t_) * D) + 2 * lane; P17_TAIL(ya, sa); P17_TAIL(yb, sb); \
            _Pragma("unroll") for (int k = 0; k < 4; ++k) { const u32x4 a = ya[k], c = yb[k]; f32x4 o0 = ov[2 * k], o1 = ov[2 * k + 1]; \
                o0.x += bf_lo(a.x) + bf_lo(c.x); o0.y += bf_hi(a.x) + bf_hi(c.x); o0.z += bf_lo(a.y) + bf_lo(c.y); o0.w += bf_hi(a.y) + bf_hi(c.y); \
                o1.x += bf_lo(a.z) + bf_lo(c.z); o1.y += bf_hi(a.z) + bf_hi(c.z); o1.z += bf_lo(a.w) + bf_lo(c.w); o1.w += bf_hi(a.w) + bf_hi(c.w); \
                if (bad) { const float q = __builtin_nanf(""); o0 = (f32x4){q, q, q, q}; o1 = o0; } \
                _op[128 * k] = o0; _op[128 * k + 1] = o1; } } while (0)
        { u32x4 yaA[4], ybA[4], yaB[4], ybB[4]; f32x4 ovA[8], ovB[8]; int saA, sbA, saB, sbB;
          const float* PART = (const float*)(ws + WS_PART);
          int nMt = tab_tile[255]; nMt = nMt > SLOTS_MAX / 256 ? SLOTS_MAX / 256 : nMt; const int Sk = tail_split(nMt - TAIL_PM0);
          int t = gw;
          if (t < T) { P17_LOAD(yaA, ybA, ovA, t, saA, sbA);
            for (;;) {
                const int tn = t + NGW; if (tn < T) P17_LOAD(yaB, ybB, ovB, tn, saB, sbB);
                P17_FIN(yaA, ybA, ovA, t, saA, sbA);
                if (tn >= T) break;
                t = tn + NGW; if (t < T) P17_LOAD(yaA, ybA, ovA, t, saA, sbA);
                P17_FIN(yaB, ybB, ovB, tn, saB, sbB);
                if (t >= T) break;
            } } }
#undef P17_LOAD
#undef P17_FIN
#undef P17_TAIL
    }
#undef IN
#undef BOTH
#undef GRID_BAR
}

extern "C" void kernel_launch(void* const* d_in, const int* in_sizes, int n_in, void* d_out, int out_size, void* d_ws, size_t ws_size, hipStream_t stream) {
    static int grid = 0;
    if (grid == 0) {
        if (n_in != 21 || in_sizes[0] != T * D || out_size != T * D || ws_size < WS_END) { fprintf(stderr, "kernel_launch: unexpected shapes (n_in %d, in0 %d, out %d, ws %zu need %zu); nothing launched\n", n_in, n_in > 0 ? in_sizes[0] : -1, out_size, ws_size, (size_t)WS_END); grid = -1; return; }
        int dev = 0, cus = 0, per_cu = 0;
        if (hipGetDevice(&dev) != hipSuccess || hipDeviceGetAttribute(&cus, hipDeviceAttributeMultiprocessorCount, dev) != hipSuccess) { fprintf(stderr, "kernel_launch: device query failed\n"); grid = -1; return; }
        if (hipFuncSetAttribute((const void*)fwd_kernel, hipFuncAttributeMaxDynamicSharedMemorySize, LDS_BYTES) != hipSuccess) { fprintf(stderr, "kernel_launch: hipFuncSetAttribute failed\n"); grid = -1; return; }
        if (hipOccupancyMaxActiveBlocksPerMultiprocessor(&per_cu, (const void*)fwd_kernel, NWAVES * 64, LDS_BYTES) != hipSuccess || per_cu < 1) fprintf(stderr, "kernel_launch: note: occupancy query reports %d\n", per_cu);
        (void)hipGetLastError();
        grid = cus;
        if (grid != 256) fprintf(stderr, "kernel_launch: %d CUs; the MoE routing phases need a 256-workgroup grid\n", grid);
    }
    if (grid < 0) return;
    if (hipMemsetAsync((char*)d_ws + WS_CTL, 0, CTL_ZERO_BYTES, stream) != hipSuccess) { fprintf(stderr, "kernel_launch: memset failed\n"); return; }
    Args a{};
    for (int i = 0; i < 21; ++i) a.in[i] = (const float*)d_in[i];
    a.out = (float*)d_out; a.ws = (unsigned char*)d_ws;
    for (int li = 0; li < N_LAUNCHES; ++li) {
        a.ph_lo = (N_LAUNCHES == 1) ? 0 : li; a.ph_hi = (N_LAUNCHES == 1) ? NPH : li + 1;
        hipLaunchKernelGGL(fwd_kernel, dim3(grid), dim3(NWAVES * 64), LDS_BYTES, stream, a);
        const hipError_t le = hipPeekAtLastError();
        if (le != hipSuccess) { fprintf(stderr, "kernel_launch: launch %d failed: %s\n", li, hipGetErrorName(le)); break; }
    }
}
```

```cpp
#include <hip/hip_runtime.h>
#include <cstdio>
#include <cstdint>

#ifndef PROBE_MASK
#define PROBE_MASK (0)
#endif
#ifndef ACTM_PITCH
#define ACTM_PITCH 8192
#endif
#ifndef MK_N_LAUNCHES
#define MK_N_LAUNCHES 1
#endif

#define GAS __attribute__((address_space(1)))
#define LAS __attribute__((address_space(3)))
typedef unsigned short bf16_t;
typedef short bf16x8 __attribute__((ext_vector_type(8)));
typedef short s16x4 __attribute__((ext_vector_type(4)));
typedef float f32x2 __attribute__((ext_vector_type(2)));
typedef float f32x4 __attribute__((ext_vector_type(4)));
typedef float f32x16 __attribute__((ext_vector_type(16)));
typedef unsigned u32x2 __attribute__((ext_vector_type(2)));
typedef unsigned u32x4 __attribute__((ext_vector_type(4)));
typedef __bf16 bf16x2v __attribute__((ext_vector_type(2)));
typedef GAS unsigned gu32;
typedef int i32x4 __attribute__((ext_vector_type(4)));
typedef int i32x8 __attribute__((ext_vector_type(8)));

__device__ __forceinline__ unsigned pk2(float lo, float hi) { f32x2 v = {lo, hi}; bf16x2v b = __builtin_convertvector(v, bf16x2v); return __builtin_bit_cast(unsigned, b); }
__device__ __forceinline__ unsigned pk4_fp8(float a, float b, float c, float d) {
    a = __builtin_amdgcn_fmed3f(a, -448.f, 448.f); b = __builtin_amdgcn_fmed3f(b, -448.f, 448.f); c = __builtin_amdgcn_fmed3f(c, -448.f, 448.f); d = __builtin_amdgcn_fmed3f(d, -448.f, 448.f);
    int w = __builtin_amdgcn_cvt_pk_fp8_f32(a, b, 0, false); w = __builtin_amdgcn_cvt_pk_fp8_f32(c, d, w, true); return (unsigned)w; }
__device__ __forceinline__ float bf_lo(unsigned w) { return __uint_as_float(w << 16); }
__device__ __forceinline__ float bf_hi(unsigned w) { return __uint_as_float(w & 0xffff0000u); }

constexpr int BATCH = 2, SEQ = 8192, T = BATCH * SEQ, D = 2048, NH = 16, NKV = 4, HD = 128, QKVD = 3072;
constexpr int FF = 5632, NE = 8, FFE = 7168;
constexpr int FFEP = ACTM_PITCH;
constexpr int SLOTS_MAX = 2 * T + NE * 256;
constexpr float EPS = 1e-6f;
constexpr float LOG2E = 1.4426950408889634f;
constexpr float W8_SCALE = 128.f, W8_INV = 1.f / 128.f;

__host__ __device__ __forceinline__ unsigned tile_off16k(int r7, int c7) { const int st = (r7 >> 4) * 2 + (c7 >> 6), ob = (r7 & 15) * 64 + (c7 & 63); return (unsigned)(st * 1024 + (ob ^ (((ob >> 9) & 1) << 5))); }
__host__ __device__ __forceinline__ size_t tiled_off(int row, int cb, int nkt) { return ((size_t)((row >> 7) * nkt + (cb >> 7)) << 14) + tile_off16k(row & 127, cb & 127); }
__host__ __device__ __forceinline__ int inv_perm32(int w) { return 16 * ((w >> 2) & 1) + 4 * (w >> 3) + (w & 3); }

namespace pg8 {
constexpr int BM = 256, BK = 64, HALF = 128, HTB = HALF * BK * 2, STAGE_BYTES = 8 * HTB, NXCD = 8;
__host__ __device__ __forceinline__ int lds_byte(int r, int c) { const int st = (r >> 4) * 2 + (c >> 5), rr = r & 15, cc = c & 31, ob = rr * 64 + cc * 2; return st * 1024 + (ob ^ (((ob >> 9) & 1) << 5)); }
__host__ __device__ __forceinline__ void stage_rc(int b, int& R, int& C) { const int st = b / 1024, sb = b % 1024, swz = sb ^ (((sb >> 9) & 1) << 5); R = (st >> 1) * 16 + swz / 64; C = (st & 1) * 32 + (swz % 64) / 2; }
__host__ __device__ __forceinline__ int perm32(int rho) { const int n = rho >> 4, i = rho & 15; return 8 * (i >> 2) + 4 * n + (i & 3); }

struct Unit { int pm, pn, aux; const char* a; const char* b; };
struct Gemm { int lda, ldb, nt, nktA, nktB; };

template <int WGM> struct TileOrder {
    int nM, nN, nwg, G, c;
    __device__ __forceinline__ void init(int nM_, int nN_, int G_, int c_) { nM = nM_; nN = nN_; nwg = nM * nN; G = G_; c = c_; }
    __device__ __forceinline__ bool tile(int i, int& pm, int& pn) const {
        const long L = (long)i * G + c; if (L >= nwg) return false;
        int wgid = (int)L; { const int q = nwg / NXCD, r = nwg % NXCD, xcd = wgid % NXCD, off = wgid / NXCD; wgid = (xcd < r ? xcd * (q + 1) : r * (q + 1) + (xcd - r) * q) + off; }
        const int nig = WGM * nN, gid = wgid / nig, fm = gid * WGM, gsz = (nM - fm) < WGM ? (nM - fm) : WGM;
        pm = fm + ((wgid % nig) % gsz); pn = (wgid % nig) / gsz; return true;
    }
};
struct DenseSched {
    TileOrder<8> o; const char* A; const char* B; size_t astep, bstep;
    __device__ __forceinline__ void init(const bf16_t* A_, const bf16_t* B_, int M, int N, int lda, int ldb, int G, int c) { o.init(M / BM, N / BM, G, c); A = (const char*)A_; B = (const char*)B_; astep = (size_t)BM * lda * 2; bstep = (size_t)BM * ldb * 2; }
    __device__ __forceinline__ bool next(int i, Unit& u) const { if (!o.tile(i, u.pm, u.pn)) return false; u.a = A + (size_t)u.pm * astep; u.b = B + (size_t)u.pn * bstep; return true; }
};
struct WprodSched {
    int G, c; const char* A; const char* B;
    __device__ __forceinline__ void init(const bf16_t* A_, const bf16_t* B_, int G_, int c_) { G = G_; c = c_; A = (const char*)A_; B = (const char*)B_; }
    __device__ __forceinline__ bool next(int i, Unit& u) const { const int L = i * G + c; if (L >= 64) return false;
        const int g = L >> 4, pm = (L >> 1) & 7, pn = L & 1; u.pm = pm; u.pn = g * 2 + pn;
        u.a = A + ((size_t)pm * BM * D + (size_t)g * 512) * 2; u.b = B + ((size_t)(g * 512 + pn * BM) * 512) * 2; return true; }
};
struct MoeSched {
    TileOrder<8> o; const char* A; const char* B; size_t astep, bstep, estep; const LAS int* te;
    __device__ __forceinline__ void init(const bf16_t* A_, const bf16_t* B_, int nM, int nper, int lda, int ldb, const LAS int* te_, int G, int c) {
        o.init(nM, nper / BM, G, c); A = (const char*)A_; B = (const char*)B_; astep = (size_t)BM * lda * 2; bstep = (size_t)BM * ldb * 2; estep = (size_t)nper * ldb * 2; te = te_; }
    __device__ __forceinline__ bool next(int i, Unit& u) const { if (!o.tile(i, u.pm, u.pn)) return false;
        const int e = __builtin_amdgcn_readfirstlane(te[u.pm]); u.a = A + (size_t)u.pm * astep; u.b = B + (size_t)e * estep + (size_t)u.pn * bstep; return true; }
};

struct MoeTailSched {
    int nsu, S, pm0, G, c; const char* A; const char* B; size_t astep, bstep, estep, kbytes; const LAS int* te;
    __device__ __forceinline__ void init(const bf16_t* A_, const bf16_t* B_, int pm0_, int R, int S_, int nper, int lda, int ldb, const LAS int* te_, int G_, int c_) {
        nsu = R * 8 * S_; S = S_; pm0 = pm0_; G = G_; c = c_; A = (const char*)A_; B = (const char*)B_; astep = (size_t)BM * lda * 2; bstep = (size_t)BM * ldb * 2; estep = (size_t)nper * ldb * 2; kbytes = (size_t)(FFE / 128 / S_) * 16384; te = te_; }
    __device__ __forceinline__ bool next(int i, Unit& u) const { const int L = i * G + c; if (L >= nsu) return false;
        const int ut = L / S, kp = L - ut * S; u.pm = pm0 + (ut >> 3); u.pn = ut & 7; u.aux = L;
        const int e = __builtin_amdgcn_readfirstlane(te[u.pm]); u.a = A + (size_t)u.pm * astep + (size_t)kp * kbytes; u.b = B + (size_t)e * estep + (size_t)u.pn * bstep + (size_t)kp * kbytes; return true; }
};

struct EpiBf16 {
    static constexpr bool PERM = true;
    bf16_t* O; int ldc; const float* cscale; unsigned* cmax;
    __device__ __forceinline__ void operator()(const f32x4 (&acc)[2][2][4][2], const Unit& u, int wr, int wc, int fr, int fq) const {
        const int row0 = u.pm * BM + wr * 64 + fr, col0 = u.pn * BM + wc * 32 + 8 * fq;
        f32x4 sv[2][2];
#pragma unroll
        for (int bj = 0; bj < 2; ++bj)
#pragma unroll
            for (int n = 0; n < 2; ++n) sv[bj][n] = cscale ? *(const f32x4*)(cscale + col0 + bj * HALF + 4 * n) : (f32x4){1.f, 1.f, 1.f, 1.f};
#pragma unroll
        for (int ai = 0; ai < 2; ++ai)
#pragma unroll
            for (int m = 0; m < 4; ++m) { bf16_t* rowp = O + (size_t)(row0 + ai * HALF + m * 16) * ldc + col0;
                float mx = 0.f;
#pragma unroll
                for (int bj = 0; bj < 2; ++bj) { const f32x4 v0 = acc[ai][bj][m][0] * sv[bj][0], v1 = acc[ai][bj][m][1] * sv[bj][1];
                    u32x4 w; w.x = pk2(v0[0], v0[1]); w.y = pk2(v0[2], v0[3]); w.z = pk2(v1[0], v1[1]); w.w = pk2(v1[2], v1[3]);
                    mx = fmaxf(mx, fmaxf(fmaxf(fmaxf(fabsf(v0[0]), fabsf(v0[1])), fmaxf(fabsf(v0[2]), fabsf(v0[3]))), fmaxf(fmaxf(fabsf(v1[0]), fabsf(v1[1])), fmaxf(fabsf(v1[2]), fabsf(v1[3])))));
                    *(u32x4*)(rowp + bj * HALF) = w; }
                if (cmax) { mx = fmaxf(mx, __shfl_xor(mx, 16)); mx = fmaxf(mx, __shfl_xor(mx, 32)); if (fq == 0) atomicMax(cmax + row0 + ai * HALF + m * 16, __float_as_uint(mx)); } }
    }
};
__device__ __forceinline__ float swiglu1(float g, float u) { return g * u * __builtin_amdgcn_rcpf(1.0f + __builtin_amdgcn_exp2f(-LOG2E * g)); }
__device__ __forceinline__ f32x2 swiglu_pk(f32x2 g, f32x2 u, float ke, float ci) {
    const f32x2 t = g * ke; f32x2 e; e.x = __builtin_amdgcn_exp2f(t.x); e.y = __builtin_amdgcn_exp2f(t.y);
    const f32x2 d = e * ci + ci; f32x2 r; r.x = __builtin_amdgcn_rcpf(d.x); r.y = __builtin_amdgcn_rcpf(d.y);
    return (g * u) * r; }
struct EpiSwiGLU {
    static constexpr bool PERM = true;
    bf16_t* O; int ldc; int nkt;
    __device__ __forceinline__ void operator()(const f32x4 (&acc)[2][2][4][2], const Unit& u, int wr, int wc, int fr, int fq) const {
        const int row0 = u.pm * BM + wr * 64 + fr, col0 = u.pn * HALF + wc * 32 + 8 * fq;
        const unsigned toff = tile_off16k(wr * 64 + fr, (wc & 1) * 64 + 16 * fq);
#pragma unroll
        for (int ai = 0; ai < 2; ++ai)
#pragma unroll
            for (int m = 0; m < 4; ++m) { bf16_t* rowp = nkt ? (bf16_t*)((unsigned char*)O + (((size_t)((u.pm * 2 + ai) * nkt + 2 * u.pn + (wc >> 1))) << 14) + toff + m * 2048) : O + (size_t)(row0 + ai * HALF + m * 16) * ldc + col0;
                const f32x4 g0 = acc[ai][0][m][0], g1 = acc[ai][0][m][1], u0 = acc[ai][1][m][0], u1 = acc[ai][1][m][1];
                u32x4 w; w.x = pk2(swiglu1(g0[0], u0[0]), swiglu1(g0[1], u0[1])); w.y = pk2(swiglu1(g0[2], u0[2]), swiglu1(g0[3], u0[3]));
                w.z = pk2(swiglu1(g1[0], u1[0]), swiglu1(g1[1], u1[1])); w.w = pk2(swiglu1(g1[2], u1[2]), swiglu1(g1[3], u1[3]));
                *(u32x4*)rowp = w; }
    }
};
struct EpiBf16i8 {
    static constexpr bool PERM = true;
    bf16_t* O; int ldc; const float* sA; const float* sW;
    __device__ __forceinline__ void operator()(const f32x4 (&acc)[2][2][4][2], const Unit& u, int wr, int wc, int fr, int fq) const {
        const int row0 = u.pm * BM + wr * 64 + fr, col0 = u.pn * BM + wc * 32 + 8 * fq;
        f32x4 sv[2][2];
#pragma unroll
        for (int bj = 0; bj < 2; ++bj)
#pragma unroll
            for (int n = 0; n < 2; ++n) sv[bj][n] = *(const f32x4*)(sW + col0 + bj * HALF + 4 * n);
#pragma unroll
        for (int ai = 0; ai < 2; ++ai)
#pragma unroll
            for (int m = 0; m < 4; ++m) { const int row = row0 + ai * HALF + m * 16; const float ra = sA[row]; bf16_t* rowp = O + (size_t)row * ldc + col0;
#pragma unroll
                for (int bj = 0; bj < 2; ++bj) { const f32x4 v0 = __builtin_convertvector(__builtin_bit_cast(i32x4, acc[ai][bj][m][0]), f32x4) * (sv[bj][0] * ra), v1 = __builtin_convertvector(__builtin_bit_cast(i32x4, acc[ai][bj][m][1]), f32x4) * (sv[bj][1] * ra);
                    u32x4 w; w.x = pk2(v0[0], v0[1]); w.y = pk2(v0[2], v0[3]); w.z = pk2(v1[0], v1[1]); w.w = pk2(v1[2], v1[3]);
                    *(u32x4*)(rowp + bj * HALF) = w; } }
    }
};
struct EpiSwiGLUi8 {
    static constexpr bool PERM = true;
    bf16_t* O; int ldc; int nkt; const float* sA; const float* sW; int o8;
    __device__ __forceinline__ void operator()(const f32x4 (&acc)[2][2][4][2], const Unit& u, int wr, int wc, int fr, int fq) const {
        const int row0 = u.pm * BM + wr * 64 + fr, col0 = u.pn * HALF + wc * 32 + 8 * fq;
        const unsigned toff = tile_off16k(wr * 64 + fr, (wc & 1) * 64 + 16 * fq), toff8 = tile_off16k(wr * 64 + fr, wc * 32 + 8 * fq);
        const float* swp = sW + u.pn * BM + wc * 32 + 8 * fq;
        const f32x4 wg0 = *(const f32x4*)swp, wg1 = *(const f32x4*)(swp + 4), wu0 = *(const f32x4*)(swp + HALF), wu1 = *(const f32x4*)(swp + HALF + 4);
#pragma unroll
        for (int ai = 0; ai < 2; ++ai)
#pragma unroll
            for (int m = 0; m < 4; ++m) { const int row = row0 + ai * HALF + m * 16; const float ra = sA[row];
                bf16_t* rowp = nkt ? (bf16_t*)((unsigned char*)O + (((size_t)((u.pm * 2 + ai) * nkt + 2 * u.pn + (wc >> 1))) << 14) + toff + m * 2048) : O + (size_t)row * ldc + col0;
                const i32x4 ig0 = __builtin_bit_cast(i32x4, acc[ai][0][m][0]), ig1 = __builtin_bit_cast(i32x4, acc[ai][0][m][1]), iu0 = __builtin_bit_cast(i32x4, acc[ai][1][m][0]), iu1 = __builtin_bit_cast(i32x4, acc[ai][1][m][1]);
                const f32x4 g0 = __builtin_convertvector(ig0, f32x4) * wg0, g1 = __builtin_convertvector(ig1, f32x4) * wg1, u0 = __builtin_convertvector(iu0, f32x4) * wu0, u1 = __builtin_convertvector(iu1, f32x4) * wu1;
                if (o8) { const float ke = -LOG2E * ra, ci = 1.0f / (ra * ra);
                    const f32x2 a0 = swiglu_pk((f32x2){g0[0], g0[1]}, (f32x2){u0[0], u0[1]}, ke, ci), a1 = swiglu_pk((f32x2){g0[2], g0[3]}, (f32x2){u0[2], u0[3]}, ke, ci),
                                a2 = swiglu_pk((f32x2){g1[0], g1[1]}, (f32x2){u1[0], u1[1]}, ke, ci), a3 = swiglu_pk((f32x2){g1[2], g1[3]}, (f32x2){u1[2], u1[3]}, ke, ci);
                    u32x2 w8; w8.x = pk4_fp8(a0.x, a0.y, a1.x, a1.y); w8.y = pk4_fp8(a2.x, a2.y, a3.x, a3.y);
                    *(u32x2*)((unsigned char*)O + (((size_t)((u.pm * 2 + ai) * nkt + u.pn)) << 14) + toff8 + m * 2048) = w8; }
                else { const f32x4 G0 = g0 * ra, G1 = g1 * ra, U0 = u0 * ra, U1 = u1 * ra;
                u32x4 w; w.x = pk2(swiglu1(G0[0], U0[0]), swiglu1(G0[1], U0[1])); w.y = pk2(swiglu1(G0[2], U0[2]), swiglu1(G0[3], U0[3]));
                w.z = pk2(swiglu1(G1[0], U1[0]), swiglu1(G1[1], U1[1])); w.w = pk2(swiglu1(G1[2], U1[2]), swiglu1(G1[3], U1[3]));
                *(u32x4*)rowp = w; } }
    }
};
struct EpiSwiGLU8 {
    static constexpr bool PERM = true;
    unsigned char* O; int ldc; float sin; int nkt;
    __device__ __forceinline__ void operator()(const f32x4 (&acc)[2][2][4][2], const Unit& u, int wr, int wc, int fr, int fq) const {
        const int row0 = u.pm * BM + wr * 64 + fr, col0 = u.pn * HALF + wc * 32 + 8 * fq;
        const unsigned toff = tile_off16k(wr * 64 + fr, wc * 32 + 8 * fq);
#pragma unroll
        for (int ai = 0; ai < 2; ++ai)
#pragma unroll
            for (int m = 0; m < 4; ++m) { unsigned char* rowp = nkt ? O + (((size_t)((u.pm * 2 + ai) * nkt + u.pn)) << 14) + toff + m * 2048 : O + (size_t)(row0 + ai * HALF + m * 16) * ldc + col0;
                const f32x4 g0 = acc[ai][0][m][0], g1 = acc[ai][0][m][1], u0 = acc[ai][1][m][0], u1 = acc[ai][1][m][1];
                const float ke = -LOG2E * sin, ci = 1.0f / (sin * sin);
                const f32x2 a0 = swiglu_pk((f32x2){g0[0], g0[1]}, (f32x2){u0[0], u0[1]}, ke, ci), a1 = swiglu_pk((f32x2){g0[2], g0[3]}, (f32x2){u0[2], u0[3]}, ke, ci),
                            a2 = swiglu_pk((f32x2){g1[0], g1[1]}, (f32x2){u1[0], u1[1]}, ke, ci), a3 = swiglu_pk((f32x2){g1[2], g1[3]}, (f32x2){u1[2], u1[3]}, ke, ci);
                u32x2 w; w.x = pk4_fp8(a0.x, a0.y, a1.x, a1.y); w.y = pk4_fp8(a2.x, a2.y, a3.x, a3.y);
                *(u32x2*)rowp = w; }
    }
};
struct EpiRes {
    static constexpr bool PERM = false;
    const float* base; float* out; int ldc; float sc;
    __device__ __forceinline__ void operator()(const f32x4 (&acc)[2][2][4][2], const Unit& u, int wr, int wc, int fr, int fq) const {
        const int row0 = u.pm * BM + wr * 64 + fr, col0 = u.pn * BM + wc * 32 + 4 * fq;
#pragma unroll
        for (int ai = 0; ai < 2; ++ai)
#pragma unroll
            for (int m = 0; m < 4; ++m) { const size_t off = (size_t)(row0 + ai * HALF + m * 16) * ldc + col0;
#pragma unroll
                for (int bj = 0; bj < 2; ++bj)
#pragma unroll
                    for (int n = 0; n < 2; ++n) { const f32x4 bs = *(const f32x4*)(base + off + bj * HALF + n * 16); *(f32x4*)(out + off + bj * HALF + n * 16) = bs + acc[ai][bj][m][n] * sc; } }
    }
};
struct EpiResI8 {
    static constexpr bool PERM = false;
    const float* base; float* out; int ldc; const float* sA; const float* sW;
    __device__ __forceinline__ void operator()(const f32x4 (&acc)[2][2][4][2], const Unit& u, int wr, int wc, int fr, int fq) const {
        const int row0 = u.pm * BM + wr * 64 + fr, col0 = u.pn * BM + wc * 32 + 4 * fq;
        f32x4 sv[2][2];
#pragma unroll
        for (int bj = 0; bj < 2; ++bj)
#pragma unroll
            for (int n = 0; n < 2; ++n) sv[bj][n] = *(const f32x4*)(sW + col0 + bj * HALF + n * 16);
#pragma unroll
        for (int ai = 0; ai < 2; ++ai)
#pragma unroll
            for (int m = 0; m < 4; ++m) { const int row = row0 + ai * HALF + m * 16; const float ra = sA[row]; const size_t off = (size_t)row * ldc + col0;
#pragma unroll
                for (int bj = 0; bj < 2; ++bj)
#pragma unroll
                    for (int n = 0; n < 2; ++n) { const f32x4 bs = *(const f32x4*)(base + off + bj * HALF + n * 16);
                        *(f32x4*)(out + off + bj * HALF + n * 16) = bs + __builtin_convertvector(__builtin_bit_cast(i32x4, acc[ai][bj][m][n]), f32x4) * (sv[bj][n] * ra); } }
    }
};
struct EpiRowScaleBf16 {
    static constexpr bool PERM = true;
    bf16_t* O; int ldc; const float* rscale; float sin;
    __device__ __forceinline__ void operator()(const f32x4 (&acc)[2][2][4][2], const Unit& u, int wr, int wc, int fr, int fq) const {
        const int row0 = u.pm * BM + wr * 64 + fr, col0 = u.pn * BM + wc * 32 + 8 * fq;
#pragma unroll
        for (int ai = 0; ai < 2; ++ai)
#pragma unroll
            for (int m = 0; m < 4; ++m) { const int row = row0 + ai * HALF + m * 16; const float rs = rscale[row] * sin; bf16_t* rowp = O + (size_t)row * ldc + col0;
#pragma unroll
                for (int bj = 0; bj < 2; ++bj) { const f32x4 v0 = acc[ai][bj][m][0] * rs, v1 = acc[ai][bj][m][1] * rs;
                    u32x4 w; w.x = pk2(v0[0], v0[1]); w.y = pk2(v0[2], v0[3]); w.z = pk2(v1[0], v1[1]); w.w = pk2(v1[2], v1[3]);
                    *(u32x4*)(rowp + bj * HALF) = w; } }
    }
};

struct EpiPartF32 {
    static constexpr bool PERM = true;
    float* P; const float* rscale; float sin;
    __device__ __forceinline__ void operator()(const f32x4 (&acc)[2][2][4][2], const Unit& u, int wr, int wc, int fr, int fq) const {
        float* base = P + (size_t)u.aux * 65536; const int r0 = wr * 64 + fr, c0 = wc * 32 + 8 * fq;
#pragma unroll
        for (int ai = 0; ai < 2; ++ai)
#pragma unroll
            for (int m = 0; m < 4; ++m) { const int r = r0 + ai * HALF + m * 16; const float rs = rscale[u.pm * BM + r] * sin; float* rowp = base + r * 256 + c0;
#pragma unroll
                for (int bj = 0; bj < 2; ++bj)
#pragma unroll
                    for (int n = 0; n < 2; ++n) *(f32x4*)(rowp + bj * HALF + n * 4) = acc[ai][bj][m][n] * rs; }
    }
};

__device__ __forceinline__ i32x8 cat8(bf16x8 lo, bf16x8 hi) { const i32x4 a = __builtin_bit_cast(i32x4, lo), b = __builtin_bit_cast(i32x4, hi); return __builtin_shufflevector(a, b, 0, 1, 2, 3, 4, 5, 6, 7); }
template <class Epi, class Sched, int MODE = 0  , bool ALIGN_EPI = true>
__device__ __forceinline__ void gemm_phase(LAS unsigned char* lds, const Gemm g, const Sched& S, const Epi& E) {
    const int tid = threadIdx.x, wid = __builtin_amdgcn_readfirstlane(tid >> 6), lane = tid & 63, wr = wid >> 2, wc = wid & 3, fr = lane & 15, fq = lane >> 4;
    const int nt = g.nt;
    unsigned voffA[2], voffB[2];
#pragma unroll
    for (int i = 0; i < 2; ++i) { int R, C; stage_rc(tid * 16 + i * 8192, R, C); const int Rb = Epi::PERM ? ((R & ~31) + perm32(R & 31)) : R;
        voffA[i] = g.nktA ? (unsigned)(tid * 16 + i * 8192) : (unsigned)(R * g.lda + C) * 2u; voffB[i] = g.nktB ? (unsigned)(tid * 16 + i * 8192) : (unsigned)(Rb * g.ldb + C) * 2u; }
    const size_t kstepA = g.nktA ? (size_t)16384 : (size_t)(BK * 2), kstepB = g.nktB ? (size_t)16384 : (size_t)(BK * 2);
    const size_t hstepA = g.nktA ? (size_t)g.nktA * 16384 : (size_t)HALF * g.lda * 2, hstepB = g.nktB ? (size_t)g.nktB * 16384 : (size_t)HALF * g.ldb * 2;
    const unsigned ldsw = (unsigned)wid * 1024u;
    const int aoff = lds_byte(wr * 64 + fr, fq * 8), boff = lds_byte(wc * 32 + fr, fq * 8);
#define PG8_SA(b, h) (((b) * 2 + (h)) * HTB)
#define PG8_SB(b, h) ((4 + (b) * 2 + (h)) * HTB)
#define PG8_STAGE(bufoff, gbase, voff) do { const char* _gb = (const char*)(gbase); asm volatile("" : "+s"(_gb)); _Pragma("unroll") for (int _i = 0; _i < 2; ++_i) \
        { unsigned _vo = (voff)[_i]; asm volatile("" : "+v"(_vo)); __builtin_amdgcn_global_load_lds((const unsigned*)(_gb + _vo), (LAS unsigned*)(lds + (bufoff) + ldsw + _i * 8192), 16, 0, 0); } } while (0)
#define PG8_LDA(dst, b, h) do { _Pragma("unroll") for (int m = 0; m < 4; ++m) _Pragma("unroll") for (int k = 0; k < 2; ++k) dst[m][k] = *(const LAS bf16x8*)(lds + PG8_SA(b, h) + aoff + m * 2048 + k * 1024); } while (0)
#define PG8_LDB(dst, b, h) do { _Pragma("unroll") for (int n = 0; n < 2; ++n) _Pragma("unroll") for (int k = 0; k < 2; ++k) dst[n][k] = *(const LAS bf16x8*)(lds + PG8_SB(b, h) + boff + n * 2048 + k * 1024); } while (0)
#define PG8_MMA(ai, bj, At, Bt) do { __builtin_amdgcn_s_setprio(1); _Pragma("unroll") for (int m = 0; m < 4; ++m) _Pragma("unroll") for (int n = 0; n < 2; ++n) { \
        if constexpr (MODE == 1) { asm volatile("v_mfma_f32_16x16x128_f8f6f4 %0, %1, %2, %0" : "+v"(acc[ai][bj][m][n]) : "v"(cat8(Bt[n][0], Bt[n][1])), "v"(cat8(At[m][0], At[m][1]))); } \
        else if constexpr (MODE == 2) { _Pragma("unroll") for (int k = 0; k < 2; ++k) asm volatile("v_mfma_i32_16x16x64_i8 %0, %1, %2, %0" : "+v"(acc[ai][bj][m][n]) : "v"(Bt[n][k]), "v"(At[m][k])); } \
        else { _Pragma("unroll") for (int k = 0; k < 2; ++k) acc[ai][bj][m][n] = __builtin_amdgcn_mfma_f32_16x16x32_bf16(Bt[n][k], At[m][k], acc[ai][bj][m][n], 0, 0, 0); } } \
        __builtin_amdgcn_s_setprio(0); } while (0)
#define PG8_MMA0(ai, bj, At, Bt) do { __builtin_amdgcn_s_setprio(1); _Pragma("unroll") for (int m = 0; m < 4; ++m) _Pragma("unroll") for (int n = 0; n < 2; ++n) { \
        if constexpr (MODE == 1) { asm volatile("v_mfma_f32_16x16x128_f8f6f4 %0, %1, %2, 0" : "=&v"(acc[ai][bj][m][n]) : "v"(cat8(Bt[n][0], Bt[n][1])), "v"(cat8(At[m][0], At[m][1]))); } \
        else if constexpr (MODE == 2) { asm volatile("v_mfma_i32_16x16x64_i8 %0, %1, %2, 0" : "=&v"(acc[ai][bj][m][n]) : "v"(Bt[n][0]), "v"(At[m][0])); \
                                        asm volatile("v_mfma_i32_16x16x64_i8 %0, %1, %2, %0" : "+v"(acc[ai][bj][m][n]) : "v"(Bt[n][1]), "v"(At[m][1])); } \
        else { acc[ai][bj][m][n] = __builtin_amdgcn_mfma_f32_16x16x32_bf16(Bt[n][0], At[m][0], (f32x4){0.f, 0.f, 0.f, 0.f}, 0, 0, 0); acc[ai][bj][m][n] = __builtin_amdgcn_mfma_f32_16x16x32_bf16(Bt[n][1], At[m][1], acc[ai][bj][m][n], 0, 0, 0); } } \
        __builtin_amdgcn_s_setprio(0); } while (0)
#define PG8_WAIT_V(n) asm volatile("s_waitcnt vmcnt(" #n ")" ::: "memory")
#define PG8_WAIT_L(n) asm volatile("s_waitcnt lgkmcnt(" #n ")" ::: "memory")
#define PG8_BAR __builtin_amdgcn_s_barrier()
#define PG8_SCHED __builtin_amdgcn_sched_barrier(0)
    Unit cur, nxt; int ui = 0;
    if (!S.next(0, cur)) return;
    f32x4 acc[2][2][4][2];
    bf16x8 At[4][2], B0[2][2], B1[2][2];
    const char* cA = cur.a; const char* cB = cur.b;
    PG8_STAGE(PG8_SB(0, 0), cB, voffB); PG8_STAGE(PG8_SB(0, 1), cB + hstepB, voffB); PG8_STAGE(PG8_SA(0, 0), cA, voffA); PG8_STAGE(PG8_SA(0, 1), cA + hstepA, voffA);
    if (wr == 1) PG8_BAR;
    PG8_WAIT_V(2); PG8_BAR;
    PG8_STAGE(PG8_SB(1, 0), cB + kstepB, voffB); PG8_STAGE(PG8_SA(1, 0), cA + kstepA, voffA); PG8_STAGE(PG8_SB(1, 1), cB + hstepB + kstepB, voffB);
    PG8_WAIT_V(6); PG8_BAR;
    for (;;) {
        const bool has_next = S.next(ui + 1, nxt);
        const char* nA = has_next ? nxt.a : cA; const char* nB = has_next ? nxt.b : cB;
        for (int t = 0; t < nt; t += 2) {
            const bool last = (t == nt - 2);
            const char* a1 = cA + (size_t)(t + 1) * kstepA;
            const char* a2 = last ? nA : cA + (size_t)(t + 2) * kstepA; const char* b2 = last ? nB : cB + (size_t)(t + 2) * kstepB;
            const char* a3 = a2 + kstepA; const char* b3 = b2 + kstepB;
            PG8_LDB(B0, 0, 0); PG8_LDB(B1, 0, 1); PG8_SCHED; PG8_LDA(At, 0, 0); PG8_STAGE(PG8_SA(1, 1), a1 + hstepA, voffA);
            PG8_WAIT_V(8); PG8_WAIT_L(0); PG8_BAR; if (t == 0) { PG8_MMA0(0, 0, At, B0); PG8_MMA0(0, 1, At, B1); } else { PG8_MMA(0, 0, At, B0); PG8_MMA(0, 1, At, B1); } PG8_BAR; PG8_SCHED;
            PG8_LDA(At, 0, 1); PG8_STAGE(PG8_SB(0, 0), b2, voffB); PG8_STAGE(PG8_SB(0, 1), b2 + hstepB, voffB); PG8_STAGE(PG8_SA(0, 0), a2, voffA);
            PG8_WAIT_V(8); PG8_WAIT_L(0); PG8_BAR; if (t == 0) { PG8_MMA0(1, 0, At, B0); PG8_MMA0(1, 1, At, B1); } else { PG8_MMA(1, 0, At, B0); PG8_MMA(1, 1, At, B1); } PG8_BAR; PG8_SCHED;
            PG8_LDB(B0, 1, 0); PG8_LDB(B1, 1, 1); PG8_SCHED; PG8_LDA(At, 1, 0); PG8_STAGE(PG8_SA(0, 1), a2 + hstepA, voffA);
            PG8_WAIT_V(8); PG8_WAIT_L(0); PG8_BAR; PG8_MMA(0, 0, At, B0); PG8_MMA(0, 1, At, B1); PG8_BAR; PG8_SCHED;
            PG8_LDA(At, 1, 1); PG8_STAGE(PG8_SB(1, 0), b3, voffB); PG8_STAGE(PG8_SB(1, 1), b3 + hstepB, voffB); PG8_STAGE(PG8_SA(1, 0), a3, voffA);
            PG8_WAIT_V(8); PG8_WAIT_L(0); PG8_BAR; PG8_MMA(1, 0, At, B0); PG8_MMA(1, 1, At, B1); PG8_BAR; PG8_SCHED;
        }
        if constexpr (ALIGN_EPI) { if (wr == 0) PG8_BAR; }
        if constexpr (MODE != 0) asm volatile("s_nop 15\n\ts_nop 7" ::: "memory");
        E(acc, cur, wr, wc, fr, fq);
        if (!has_next) break;
        cur = nxt; cA = nA; cB = nB; ++ui;
        if constexpr (ALIGN_EPI) { if (wr == 1) PG8_BAR; }
    }
    PG8_WAIT_V(0);
    if constexpr (!ALIGN_EPI) { if (wr == 0) PG8_BAR; }
    PG8_BAR;
#undef PG8_SA
#undef PG8_SB
#undef PG8_STAGE
#undef PG8_LDA
#undef PG8_LDB
#undef PG8_MMA
#undef PG8_MMA0
#undef PG8_WAIT_V
#undef PG8_WAIT_L
#undef PG8_BAR
#undef PG8_SCHED
}
}

constexpr int NWAVES = 8;
constexpr int NPH = 19;
constexpr int N_LAUNCHES = MK_N_LAUNCHES;
static_assert(N_LAUNCHES == 1 || N_LAUNCHES == NPH, "MK_N_LAUNCHES must be 1 or 19");

constexpr size_t MiB = 1u << 20;
constexpr size_t WS_CTL = 0, CTL_ZERO_BYTES = 1 * MiB;
constexpr size_t WS_TAB = 1 * MiB;
constexpr size_t TAB_TE = 0, TAB_TW = 64 * 1024, TAB_CNT = 192 * 1024, TAB_SLOT = 256 * 1024, TAB_WSLOT = 384 * 1024, TAB_TILE = 640 * 1024, TAB_SA = 768 * 1024, TAB_SW = 832 * 1024;
constexpr size_t CTL_CMAX = 65536;
constexpr size_t WS_WQKV = 3 * MiB;
constexpr size_t WS_WO = WS_WQKV + (size_t)QKVD * D * 2;
constexpr size_t WS_WGU = WS_WO + (size_t)D * D * 2;
constexpr size_t WS_WD = WS_WGU + (size_t)2 * FF * D * 2;
constexpr size_t WS_WIN = WS_WD + (size_t)D * FF * 2;
constexpr size_t WS_WG = WS_WIN + (size_t)D * D * 2;
constexpr size_t WS_WOUT = WS_WG + (size_t)4 * 512 * 512 * 2;
constexpr size_t WS_WMGU = WS_WOUT + (size_t)D * D * 2;
constexpr size_t WS_WMD = WS_WMGU + (size_t)NE * 2 * FFE * D * 2;
constexpr size_t WS_H = WS_WMD + (size_t)NE * D * FFE * 2;
constexpr size_t WS_BIG = WS_H + (size_t)T * D * 2;
constexpr size_t BIG_BYTES = (size_t)SLOTS_MAX * FFE * 2;
static_assert((size_t)SLOTS_MAX * FFEP <= 288 * MiB && 288 * MiB + 64 * MiB <= BIG_BYTES, "ACTM + partials fit");
constexpr size_t WS_QKV = WS_BIG, WS_AO = WS_BIG + (size_t)T * QKVD * 2, WS_ACT = WS_AO + (size_t)T * D * 2;
constexpr size_t WS_U = WS_BIG, WS_DD = WS_U + (size_t)T * D * 2, WS_Y = WS_DD + (size_t)T * D * 2;
constexpr size_t WS_ACTM = WS_BIG;
constexpr size_t WS_PART = WS_BIG + 288 * MiB;
constexpr size_t WS_WGU8 = WS_BIG + 400 * MiB;
constexpr size_t WS_HS = WS_BIG + BIG_BYTES;
constexpr size_t WS_END = WS_HS + (size_t)SLOTS_MAX * D * 2;
static_assert(WS_ACT + (size_t)T * FF * 2 <= WS_BIG + BIG_BYTES && WS_Y + (size_t)T * D * 2 <= WS_BIG + BIG_BYTES, "overlays fit");
static_assert(WS_WQKV % 256 == 0 && WS_H % 256 == 0 && WS_BIG % 256 == 0 && WS_HS % 256 == 0, "alignment");

constexpr int TAIL_PM0 = 128;
__host__ __device__ __forceinline__ int tail_split(int R) { return R <= 2 ? 14 : (R <= 4 ? 7 : 4); }
constexpr int CW_TMO = 0;
constexpr int CW_BAR = 4096;

constexpr int RING_OFF = 0, RING_BYTES = 131072;
constexpr int LTAB_OFF = 135168;
constexpr int MISC_OFF = LTAB_OFF + 1024;
constexpr int LDS_BYTES = 147456;

#define RLX_AGENT __ATOMIC_RELAXED, __HIP_MEMORY_SCOPE_AGENT
#define LDS_WAIT() asm volatile("s_waitcnt lgkmcnt(0)" ::: "memory")
#define VM_WAIT() asm volatile("s_waitcnt vmcnt(0)" ::: "memory")

#define XB_TMO      128
#define XB_XCNT(j)  (256  + 64 * (j))
#define XB_XSUB(j)  (1280 + 64 * (j))
#define XB_XGEN(j)  (2304 + 64 * (j))
#define XB_TOP      3328
#define XB_TOPGEN   3392
#define XCD_BAR_WORDS 3456
#define XB_SPIN_CAP (1u << 18)
__device__ __forceinline__ unsigned xb_ld(unsigned* p)              { return __hip_atomic_load(p, __ATOMIC_RELAXED, __HIP_MEMORY_SCOPE_AGENT); }
__device__ __forceinline__ unsigned xb_add(unsigned* p, unsigned v) { return __hip_atomic_fetch_add(p, v, __ATOMIC_RELAXED, __HIP_MEMORY_SCOPE_AGENT); }
__device__ __forceinline__ unsigned xb_xcc_id() { return (unsigned)__builtin_amdgcn_s_getreg((3 << 11) | 20) & 0xFu; }
#define XB_SPIN(cond, bar) do { unsigned _sp = 0; while (cond) { __builtin_amdgcn_s_sleep(1); \
    if ((++_sp & 255u) == 0u) { if (xb_ld(&(bar)[XB_TMO])) break; if (_sp > XB_SPIN_CAP) { atomicAdd(&(bar)[XB_TMO], 1u); break; } } } } while (0)
struct XcdBarrier { unsigned* bar; unsigned x; volatile LAS unsigned* st; };
__device__ __forceinline__ XcdBarrier xcd_barrier_post(unsigned* bar, volatile LAS unsigned* st) {
    XcdBarrier b; b.bar = bar; b.x = xb_xcc_id(); b.st = st;
    if (threadIdx.x == 0) (void)xb_add(&bar[XB_XCNT(b.x)], 1u);
    return b;
}
__device__ __forceinline__ void xcd_barrier_complete(unsigned* bar, unsigned x, unsigned& nloc, unsigned& nx) {
    const unsigned G = gridDim.x * gridDim.y * gridDim.z;
    unsigned sum, cnt, mine, sp = 0u;
    for (;;) {
        sum = 0u; cnt = 0u; mine = 0u;
#pragma unroll
        for (unsigned j = 0; j < 16; ++j) { const unsigned c = xb_ld(&bar[XB_XCNT(j)]); sum += c; cnt += (c > 0u) ? 1u : 0u; mine = (j == x) ? c : mine; }
        if (sum == G) break;
        __builtin_amdgcn_s_sleep(1);
        if ((++sp & 255u) == 0u) { if (xb_ld(&bar[XB_TMO])) break; if (sp > XB_SPIN_CAP) { atomicAdd(&bar[XB_TMO], 1u); break; } }
    }
    nloc = mine > 0u ? mine : 1u; nx = cnt > 0u ? cnt : 1u;
}
__device__ __forceinline__ void xcd_barrier(const XcdBarrier& b) {
    asm volatile("s_waitcnt vmcnt(0)" ::: "memory");
    __syncthreads();
    if (threadIdx.x == 0) {
        unsigned* bar = b.bar;
        __builtin_amdgcn_s_waitcnt(0);
        unsigned nloc = b.st[0], nx = b.st[1];
        if (nloc == 0u) { xcd_barrier_complete(bar, b.x, nloc, nx); b.st[0] = nloc; b.st[1] = nx; }
        const unsigned old = xb_add(&bar[XB_XSUB(b.x)], 1u);
        const unsigned gen = old / nloc;
        if (old + 1u == (gen + 1u) * nloc) {
            __builtin_amdgcn_fence(__ATOMIC_RELEASE, "agent");
            asm volatile("s_waitcnt vmcnt(0)" ::: "memory");
            const unsigned og = xb_add(&bar[XB_TOP], 1u);
            const unsigned tg = og / nx;
            if (og + 1u == (tg + 1u) * nx) xb_add(&bar[XB_TOPGEN], 1u);
            else XB_SPIN(xb_ld(&bar[XB_TOPGEN]) == tg, bar);
            __builtin_amdgcn_fence(__ATOMIC_ACQUIRE, "agent");
            xb_add(&bar[XB_XGEN(b.x)], 1u);
            asm volatile("s_waitcnt vmcnt(0)" ::: "memory");
        } else {
            XB_SPIN(xb_ld(&bar[XB_XGEN(b.x)]) == gen, bar);
            __builtin_amdgcn_fence(__ATOMIC_ACQUIRE, "agent");
            asm volatile("s_waitcnt vmcnt(0)" ::: "memory");
        }
    }
    __syncthreads();
}

__device__ __forceinline__ float wave_sum(float v) {
#pragma unroll
    for (int o = 1; o < 64; o <<= 1) v += __shfl_xor(v, o);
    return v;
}
__device__ __forceinline__ int wave_sum_i(int v) {
#pragma unroll
    for (int o = 1; o < 64; o <<= 1) v += __shfl_xor(v, o);
    return v;
}

struct CvtDesc { const float* src; unsigned char* dst; int N; int ldd; int f8; int nkt, perm, drow0, kb0; unsigned* cmax; };
__device__ __forceinline__ void cvt_mk(CvtDesc& d, const float* W, int N, void* WT, int ldd_elems, int map, int f8, int item, int nkt = 0, int perm = 0, unsigned* cmax = nullptr) {
    const int nblk = N >> 6, kb = item / nblk, nb = item - kb * nblk, k0 = kb << 6, n0 = nb << 6;
    const int drow0 = (map == 0) ? n0 : (((n0 >> 7) << 8) + (n0 & 127) + (map == 2 ? 128 : 0)), esz = f8 ? 1 : 2;
    d.src = W + (size_t)k0 * N + n0; d.N = N; d.ldd = ldd_elems * esz; d.f8 = f8; d.nkt = nkt; d.perm = perm; d.drow0 = drow0; d.kb0 = k0 * esz; d.cmax = cmax;
    d.dst = nkt ? (unsigned char*)WT : (unsigned char*)WT + ((size_t)drow0 * ldd_elems + k0) * esz;
}
__device__ __forceinline__ unsigned char* cvt_dst(const CvtDesc& d, int n, int cbyte) {
    if (!d.nkt) return d.dst + (size_t)n * d.ldd + cbyte;
    int row = d.drow0 + n; if (d.perm) row = (row & ~31) + inv_perm32(row & 31);
    return d.dst + tiled_off(row, d.kb0 + cbyte, d.nkt);
}
__device__ __forceinline__ void cvt_load(const CvtDesc& d, f32x4 (&v)[16], int lane) {
    const float* src = d.src + (size_t)(lane >> 4) * d.N + 4 * (lane & 15);
#pragma unroll
    for (int i = 0; i < 16; ++i) v[i] = __builtin_nontemporal_load((const f32x4*)(src + (size_t)(4 * i) * d.N));
}
__device__ __forceinline__ void cvt_process(const CvtDesc& d, const f32x4 (&v)[16], LAS float* scr, int lane) {
    { const int r4 = lane >> 4, c4 = lane & 15;
#pragma unroll
      for (int i = 0; i < 16; ++i) { LAS float* p = scr + (4 * i + r4) * 65 + 4 * c4; p[0] = v[i].x; p[1] = v[i].y; p[2] = v[i].z; p[3] = v[i].w; } }
    LDS_WAIT(); asm volatile("" ::: "memory");
    const int c = lane & 7;
    if (d.f8) {
#pragma unroll
        for (int j = 0; j < 8; ++j) { const int n = (lane >> 3) + 8 * j; const LAS float* s = scr + (8 * c) * 65 + n;
            u32x2 o; o.x = pk4_fp8(s[0 * 65] * W8_SCALE, s[1 * 65] * W8_SCALE, s[2 * 65] * W8_SCALE, s[3 * 65] * W8_SCALE); o.y = pk4_fp8(s[4 * 65] * W8_SCALE, s[5 * 65] * W8_SCALE, s[6 * 65] * W8_SCALE, s[7 * 65] * W8_SCALE);
            *(u32x2*)cvt_dst(d, n, 8 * c) = o; }
    } else {
#pragma unroll
        for (int j = 0; j < 8; ++j) { const int n = (lane >> 3) + 8 * j; const LAS float* s = scr + (8 * c) * 65 + n;
            u32x4 o; o.x = pk2(s[0 * 65], s[1 * 65]); o.y = pk2(s[2 * 65], s[3 * 65]); o.z = pk2(s[4 * 65], s[5 * 65]); o.w = pk2(s[6 * 65], s[7 * 65]);
            *(u32x4*)cvt_dst(d, n, 16 * c) = o;
            if (d.cmax) {
                float mx = fmaxf(fmaxf(fmaxf(fabsf(s[0 * 65]), fabsf(s[1 * 65])), fmaxf(fabsf(s[2 * 65]), fabsf(s[3 * 65]))), fmaxf(fmaxf(fabsf(s[4 * 65]), fabsf(s[5 * 65])), fmaxf(fabsf(s[6 * 65]), fabsf(s[7 * 65]))));
                mx = fmaxf(mx, __shfl_xor(mx, 1)); mx = fmaxf(mx, __shfl_xor(mx, 2)); mx = fmaxf(mx, __shfl_xor(mx, 4));
                if (c == 0) atomicMax(d.cmax + d.drow0 + n, __float_as_uint(mx)); } }
    }
    LDS_WAIT(); asm volatile("" ::: "memory");
}


struct MoeCvtTile { const float* src; unsigned char* dst; int N; int kind; int n0; int k0; };
__device__ __forceinline__ void moe_cvt_decode(MoeCvtTile& t, int tile, const float* wg, const float* wu, const float* wd, unsigned char* Wmgu8, unsigned char* Wmd8) {
    constexpr int TPE = 448;
    const int mat = tile / (NE * TPE), r = tile - mat * (NE * TPE), e = r / TPE, q = r - e * TPE;
    if (mat < 2) { const int kb = q / 14, nb = q - kb * 14; t.src = (mat == 0 ? wg : wu) + (size_t)e * D * FFE + (size_t)(kb * 64) * FFE + nb * 512; t.N = FFE; t.kind = mat; t.n0 = nb * 512; t.k0 = kb * 64; t.dst = Wmgu8 + (size_t)e * 2 * FFE * D; }
    else { const int kb = q >> 2, nb = q & 3; t.src = wd + (size_t)e * FFE * D + (size_t)(kb * 64) * D + nb * 512; t.N = D; t.kind = 2; t.n0 = nb * 512; t.k0 = kb * 64; t.dst = Wmd8 + (size_t)e * D * FFE; }
}
__device__ __forceinline__ void moe_cvt_load(const MoeCvtTile& t, f32x4 (&v)[16], int tid) {
    const float* p = t.src + (size_t)(tid >> 7) * t.N + 4 * (tid & 127);
#pragma unroll
    for (int i = 0; i < 16; ++i) v[i] = __builtin_nontemporal_load((const f32x4*)(p + (size_t)(4 * i) * t.N));
}
__device__ __forceinline__ void moe_cvt_process(const MoeCvtTile& t, const f32x4 (&v)[16], LAS float* scr, int tid) {
    { LAS f32x4* w = (LAS f32x4*)(scr + (tid >> 7) * 512 + 4 * (tid & 127));
#pragma unroll
      for (int i = 0; i < 16; ++i) w[i * 512] = v[i]; }
    __syncthreads();
    const int n = t.n0 + tid;
    u32x4 o[4];
#pragma unroll
    for (int j = 0; j < 4; ++j) { const LAS float* s = scr + (16 * j) * 512 + tid;
        o[j].x = pk4_fp8(s[0 * 512] * W8_SCALE, s[1 * 512] * W8_SCALE, s[2 * 512] * W8_SCALE, s[3 * 512] * W8_SCALE); o[j].y = pk4_fp8(s[4 * 512] * W8_SCALE, s[5 * 512] * W8_SCALE, s[6 * 512] * W8_SCALE, s[7 * 512] * W8_SCALE);
        o[j].z = pk4_fp8(s[8 * 512] * W8_SCALE, s[9 * 512] * W8_SCALE, s[10 * 512] * W8_SCALE, s[11 * 512] * W8_SCALE); o[j].w = pk4_fp8(s[12 * 512] * W8_SCALE, s[13 * 512] * W8_SCALE, s[14 * 512] * W8_SCALE, s[15 * 512] * W8_SCALE); }
    if (t.kind < 2) { unsigned char* d = t.dst + (size_t)(((n >> 7) << 8) + (n & 127) + (t.kind == 1 ? 128 : 0)) * D + t.k0;
#pragma unroll
        for (int j = 0; j < 4; ++j) *(u32x4*)(d + 16 * j) = o[j]; }
    else { const int row = (n & ~31) + inv_perm32(n & 31);
#pragma unroll
        for (int j = 0; j < 4; ++j) *(u32x4*)(t.dst + tiled_off(row, t.k0 + 16 * j, FFE / 128)) = o[j]; }
    __syncthreads();
}

__device__ __forceinline__ void rms_load(f32x4 (&v)[8], const float* X, int m, int lane) { const f32x4* xr = (const f32x4*)(X + (size_t)m * D) + lane;
#pragma unroll
    for (int j = 0; j < 8; ++j) v[j] = xr[64 * j]; }
__device__ __forceinline__ float wave_max(float v) {
#pragma unroll
    for (int o = 1; o < 64; o <<= 1) v = fmaxf(v, __shfl_xor(v, o));
    return v;
}
__device__ __forceinline__ unsigned pk4_i8(float a, float b, float c, float d) {
    a = __builtin_amdgcn_fmed3f(a, -127.f, 127.f); b = __builtin_amdgcn_fmed3f(b, -127.f, 127.f); c = __builtin_amdgcn_fmed3f(c, -127.f, 127.f); d = __builtin_amdgcn_fmed3f(d, -127.f, 127.f);
    const unsigned ua = (unsigned)(int)(a + 128.f), ub = (unsigned)(int)(b + 128.f), uc = (unsigned)(int)(c + 128.f), ud = (unsigned)(int)(d + 128.f);
    return (ua | (ub << 8) | (uc << 16) | (ud << 24)) ^ 0x80808080u; }
__device__ __forceinline__ void rms_finish_i8(const f32x4 (&v)[8], const f32x4 (&g)[8], bf16_t* H, float* sA, int m, int lane) {
    float s = 0.f;
#pragma unroll
    for (int j = 0; j < 8; ++j) s += (v[j].x * v[j].x + v[j].y * v[j].y) + (v[j].z * v[j].z + v[j].w * v[j].w);
    const float rs = 1.0f / sqrtf(wave_sum(s) * (1.f / D) + EPS);
    f32x4 h[8]; float am = 0.f;
#pragma unroll
    for (int j = 0; j < 8; ++j) { h[j] = v[j] * rs * g[j]; am = fmaxf(am, fmaxf(fmaxf(fabsf(h[j].x), fabsf(h[j].y)), fmaxf(fabsf(h[j].z), fabsf(h[j].w)))); }
    am = fmaxf(wave_max(am), 1e-30f);
    const float inv = 127.0f / am;
    unsigned* o4 = (unsigned*)((unsigned char*)H + (size_t)m * D) + lane;
#pragma unroll
    for (int j = 0; j < 8; ++j) o4[64 * j] = pk4_i8(__builtin_rintf(h[j].x * inv), __builtin_rintf(h[j].y * inv), __builtin_rintf(h[j].z * inv), __builtin_rintf(h[j].w * inv));
    if (lane == 0) sA[m] = am * (1.0f / 127.0f);
}
__device__ __forceinline__ void rms_finish(const f32x4 (&v)[8], const f32x4 (&g)[8], bf16_t* H, int m, int lane) {
    float s = 0.f;
#pragma unroll
    for (int j = 0; j < 8; ++j) s += (v[j].x * v[j].x + v[j].y * v[j].y) + (v[j].z * v[j].z + v[j].w * v[j].w);
    const float rs = 1.0f / sqrtf(wave_sum(s) * (1.f / D) + EPS);
    u32x2* o8 = (u32x2*)(H + (size_t)m * D) + lane;
#pragma unroll
    for (int j = 0; j < 8; ++j) { u32x2 w; w.x = pk2(v[j].x * rs * g[j].x, v[j].y * rs * g[j].y); w.y = pk2(v[j].z * rs * g[j].z, v[j].w * rs * g[j].w); o8[64 * j] = w; }
}
template <bool I8 = false> __device__ __forceinline__ void rms_phase(const float* X, const float* gain, bf16_t* H, int gw, int NGW, int lane, float* sA = nullptr) {
    f32x4 g[8], va[8], vb[8];
#pragma unroll
    for (int j = 0; j < 8; ++j) g[j] = ((const f32x4*)gain + lane)[64 * j];
    int m = gw; if (m >= T) return;
    rms_load(va, X, m, lane);
    for (;;) {
        const int mn = m + NGW; if (mn < T) rms_load(vb, X, mn, lane);
        if constexpr (I8) rms_finish_i8(va, g, H, sA, m, lane); else rms_finish(va, g, H, m, lane);
        if (mn >= T) break;
        m = mn + NGW; if (m < T) rms_load(va, X, m, lane);
        if constexpr (I8) rms_finish_i8(vb, g, H, sA, mn, lane); else rms_finish(vb, g, H, mn, lane);
        if (m >= T) break;
    }
}

__device__ __forceinline__ unsigned off_b(unsigned row, unsigned ch) { return 256u * row + 16u * (ch ^ (((row & 3u) << 2) | ((row >> 2) & 3u))); }
__device__ __forceinline__ s16x4 tr_read(const LAS unsigned char* p) { return __builtin_bit_cast(s16x4, __builtin_amdgcn_ds_read_tr16_b64_v4i16((LAS s16x4*)p)); }

__device__ __forceinline__ void quant_rows_i8(const bf16_t* W, unsigned char* W8, const unsigned* cmax, float* sw, int rows, int gw, int NGW, int lane) {
    for (int n = gw; n < rows; n += NGW) {
        const float am = fmaxf(__uint_as_float(cmax[n]), 1e-30f), inv = 127.0f / am;
        const u32x4* src = (const u32x4*)(W + (size_t)n * D); u32x4* dst = (u32x4*)(W8 + (size_t)n * D) + lane;
        u32x4 wv[4];
#pragma unroll
        for (int k = 0; k < 4; ++k) wv[k] = src[2 * lane + (k & 1) + 128 * (k >> 1)];
#pragma unroll
        for (int k = 0; k < 4; k += 2) { u32x4 o; const u32x4 a = wv[k], b2 = wv[k + 1];
            o.x = pk4_i8(__builtin_rintf(bf_lo(a.x) * inv), __builtin_rintf(bf_hi(a.x) * inv), __builtin_rintf(bf_lo(a.y) * inv), __builtin_rintf(bf_hi(a.y) * inv));
            o.y = pk4_i8(__builtin_rintf(bf_lo(a.z) * inv), __builtin_rintf(bf_hi(a.z) * inv), __builtin_rintf(bf_lo(a.w) * inv), __builtin_rintf(bf_hi(a.w) * inv));
            o.z = pk4_i8(__builtin_rintf(bf_lo(b2.x) * inv), __builtin_rintf(bf_hi(b2.x) * inv), __builtin_rintf(bf_lo(b2.y) * inv), __builtin_rintf(bf_hi(b2.y) * inv));
            o.w = pk4_i8(__builtin_rintf(bf_lo(b2.z) * inv), __builtin_rintf(bf_hi(b2.z) * inv), __builtin_rintf(bf_lo(b2.w) * inv), __builtin_rintf(bf_hi(b2.w) * inv));
            dst[64 * (k >> 1)] = o; }
        if (lane == 0) sw[n] = am * (1.0f / 127.0f);
    }
}

struct Args { const float* in[21]; float* out; unsigned char* ws; int ph_lo, ph_hi; };

enum { I_X = 0, I_MIXN, I_FFNN, I_RELB, I_WQKV, I_QG, I_KG, I_SINK, I_WO, I_FG, I_FU, I_FD, I_PIN, I_PG, I_PSC, I_POUT, I_RW, I_RB, I_MG, I_MU, I_MD };

__global__ void __launch_bounds__(NWAVES * 64, 2) fwd_kernel(Args args) {
    extern __shared__ __attribute__((aligned(16))) unsigned char lds_raw[];
    LAS unsigned char* lds = (LAS unsigned char*)lds_raw;
    volatile LAS unsigned* MISC = (volatile LAS unsigned*)(lds + MISC_OFF);
    const int tid = threadIdx.x, lane = tid & 63, wave = __builtin_amdgcn_readfirstlane(tid >> 6);
    const int G = gridDim.x, bx = blockIdx.x;
    const int gw = bx * NWAVES + wave, NGW = G * NWAVES;
    unsigned char* ws = args.ws;
    gu32* ctl = (gu32*)(ws + WS_CTL);
    if (tid < 32) MISC[tid] = 0u;
    __syncthreads();
    XcdBarrier bar; bar.bar = (unsigned*)(ws + WS_CTL) + CW_BAR; bar.x = 0; bar.st = nullptr;
    if (N_LAUNCHES == 1) bar = xcd_barrier_post((unsigned*)(ws + WS_CTL) + CW_BAR, MISC + 8);
#define GRID_BAR() do { if (N_LAUNCHES == 1) xcd_barrier(bar); } while (0)
    const int lo = args.ph_lo, hi = args.ph_hi;
#define IN(k) (lo <= (k) && (k) < hi)
#define REP(k) for (int _rep = 0; _rep < (((PROBE_MASK >> (k)) & 1) ? 2 : 1); ++_rep)
#define BOTH(k) (IN(k) && IN((k) + 1))

    bf16_t* const Wqkv = (bf16_t*)(ws + WS_WQKV); bf16_t* const Wo = (bf16_t*)(ws + WS_WO); bf16_t* const Wgu = (bf16_t*)(ws + WS_WGU); bf16_t* const Wd = (bf16_t*)(ws + WS_WD);
    bf16_t* const Win = (bf16_t*)(ws + WS_WIN); bf16_t* const Wg = (bf16_t*)(ws + WS_WG); bf16_t* const Wout = (bf16_t*)(ws + WS_WOUT);
    bf16_t* const Wmgu = (bf16_t*)(ws + WS_WMGU); bf16_t* const Wmd = (bf16_t*)(ws + WS_WMD);
    bf16_t* const Hb = (bf16_t*)(ws + WS_H); bf16_t* const QKV = (bf16_t*)(ws + WS_QKV); bf16_t* const AO = (bf16_t*)(ws + WS_AO); bf16_t* const ACT = (bf16_t*)(ws + WS_ACT);
    bf16_t* const Ub = (bf16_t*)(ws + WS_U); bf16_t* const DDb = (bf16_t*)(ws + WS_DD); bf16_t* const Yb = (bf16_t*)(ws + WS_Y);
    bf16_t* const ACTM = (bf16_t*)(ws + WS_ACTM); bf16_t* const HS = (bf16_t*)(ws + WS_HS);
    int* const tab_te = (int*)(ws + WS_TAB + TAB_TE); float* const tab_tw = (float*)(ws + WS_TAB + TAB_TW); int* const tab_cnt = (int*)(ws + WS_TAB + TAB_CNT);
    int* const tab_slot = (int*)(ws + WS_TAB + TAB_SLOT); float* const tab_wslot = (float*)(ws + WS_TAB + TAB_WSLOT); int* const tab_tile = (int*)(ws + WS_TAB + TAB_TILE);
    float* const OUT = args.out;
    unsigned* const cmax_gu = (unsigned*)(ws + WS_CTL + CTL_CMAX); float* const tab_sa = (float*)(ws + WS_TAB + TAB_SA); float* const tab_sw = (float*)(ws + WS_TAB + TAB_SW);
    unsigned char* const Wgu8 = ws + WS_WGU8; unsigned char* const Wqkv8 = ws + WS_WGU8 + (size_t)2 * FF * D; unsigned char* const Win8 = Wqkv8 + (size_t)QKVD * D; bf16_t* const Wpt = (bf16_t*)(Win8 + (size_t)D * D); unsigned char* const Wpt8 = (unsigned char*)Wpt + (size_t)D * D * 2;

        LAS float* scr = (LAS float*)(lds + RING_OFF + wave * 16640);
        constexpr int I_1 = (D / 64) * (QKVD / 64), I_2 = (D / 64) * (D / 64), I_3 = (D / 64) * (FF / 64), I_7 = 0, I_M = (D / 64) * (FFE / 64);
        constexpr int E1 = I_1, E2 = E1 + I_2, E3 = E2 + I_3, E4 = E3 + I_3, E5 = E4 + I_3, E6 = E5 + I_2, E7 = E6 + I_7, E8 = E7 + I_2, E9 = E8 + NE * I_M, E10 = E9 + NE * I_M, E11 = E10 + NE * I_M;
#define CVT_DECODE(it_, d_) do { const int _it = (it_); \
            if (_it < E1) cvt_mk(d_, args.in[I_WQKV], QKVD, Wqkv, D, 0, 0, _it, 0, 0, cmax_gu + 2 * FF); \
            else if (_it < E2) cvt_mk(d_, args.in[I_WO], D, Wo, D, 0, 1, _it - E1); \
            else if (_it < E3) cvt_mk(d_, args.in[I_FG], FF, Wgu, D, 1, 0, _it - E2, 0, 0, cmax_gu); \
            else if (_it < E4) cvt_mk(d_, args.in[I_FU], FF, Wgu, D, 2, 0, _it - E3, 0, 0, cmax_gu); \
            else if (_it < E5) cvt_mk(d_, args.in[I_FD], D, Wd, FF, 0, 1, _it - E4, FF / 128, 0); \
            else if (_it < E6) cvt_mk(d_, args.in[I_PIN], D, Win, D, 0, 0, _it - E5, 0, 0, cmax_gu + 2 * FF + QKVD); \
            else if (_it < E7) { const int _r = _it - E6, _g = _r >> 6; cvt_mk(d_, args.in[I_PG] + (size_t)_g * 512 * 512, 512, Wg + (size_t)_g * 512 * 512, 512, 0, 0, _r & 63); } \
            else if (_it < E8) cvt_mk(d_, args.in[I_POUT], D, Wout, D, 0, 0, _it - E7); \
            else if (_it < E9) { const int _r = _it - E8, _e = _r / I_M; cvt_mk(d_, args.in[I_MG] + (size_t)_e * D * FFE, FFE, (unsigned char*)Wmgu + (size_t)_e * 2 * FFE * D, D, 1, 1, _r - _e * I_M); } \
            else if (_it < E10) { const int _r = _it - E9, _e = _r / I_M; cvt_mk(d_, args.in[I_MU] + (size_t)_e * D * FFE, FFE, (unsigned char*)Wmgu + (size_t)_e * 2 * FFE * D, D, 2, 1, _r - _e * I_M); } \
            else { const int _r = _it - E10, _e = _r / I_M; cvt_mk(d_, args.in[I_MD] + (size_t)_e * FFE * D, D, (unsigned char*)Wmd + (size_t)_e * D * FFE, FFE, 0, 1, _r - _e * I_M, FFE / 128, 1); } } while (0)
#define CVT_RUN(IT0, IT1) do { CvtDesc dA, dB; f32x4 vA[16], vB[16]; int it = (IT0) + gw; \
          if (it < (IT1)) { CVT_DECODE(it, dA); cvt_load(dA, vA, lane); } \
          while (it < (IT1)) { \
              int itn = it + NGW; \
              if (itn < (IT1)) { CVT_DECODE(itn, dB); cvt_load(dB, vB, lane); } \
              cvt_process(dA, vA, scr, lane); \
              it = itn; if (it >= (IT1)) break; \
              itn = it + NGW; \
              if (itn < (IT1)) { CVT_DECODE(itn, dA); cvt_load(dA, vA, lane); } \
              cvt_process(dB, vB, scr, lane); \
              it = itn; \
          } } while (0)
    if (IN(0)) { REP(0) {
        CVT_RUN(0, E8);
        for (int i8 = bx * (NWAVES * 64) + tid; i8 < 4 * 512 * 512 / 8; i8 += G * NWAVES * 64) {
            const int e0 = (i8 & 63) * 8, g_ = i8 >> 15; const float* wp = args.in[I_PG] + (size_t)i8 * 8; const float* sp = args.in[I_PSC] + g_ * 512 + e0;
            const f32x4 a = *(const f32x4*)wp, b2 = *(const f32x4*)(wp + 4), sa_ = *(const f32x4*)sp, sb_ = *(const f32x4*)(sp + 4);
            u32x4 o; o.x = pk2(a.x * sa_.x, a.y * sa_.y); o.y = pk2(a.z * sa_.z, a.w * sa_.w); o.z = pk2(b2.x * sb_.x, b2.y * sb_.y); o.w = pk2(b2.z * sb_.z, b2.w * sb_.w);
            *(u32x4*)(Wg + (size_t)i8 * 8) = o; }
        }
        if (BOTH(0)) GRID_BAR();
    }
    if (IN(1)) { REP(1) {
        { pg8::WprodSched S; S.init(Wout, Wg, G, bx);
          pg8::EpiBf16 E{Wpt, D, nullptr, cmax_gu + 2 * FF + QKVD + D};
          pg8::gemm_phase<pg8::EpiBf16, pg8::WprodSched>(lds + RING_OFF, pg8::Gemm{D, 512, 512 / 64}, S, E); }
        { LAS float* scrb = (LAS float*)(lds + RING_OFF); MoeCvtTile tA, tB; f32x4 vA[16], vB[16];
          constexpr int NTILES = 3 * NE * 448; int it = bx;
          if (it < NTILES) { moe_cvt_decode(tA, it, args.in[I_MG], args.in[I_MU], args.in[I_MD], (unsigned char*)Wmgu, (unsigned char*)Wmd); moe_cvt_load(tA, vA, tid); }
          while (it < NTILES) {
              int itn = it + G;
              if (itn < NTILES) { moe_cvt_decode(tB, itn, args.in[I_MG], args.in[I_MU], args.in[I_MD], (unsigned char*)Wmgu, (unsigned char*)Wmd); moe_cvt_load(tB, vB, tid); }
              moe_cvt_process(tA, vA, scrb, tid);
              it = itn; if (it >= NTILES) break;
              itn = it + G;
              if (itn < NTILES) { moe_cvt_decode(tA, itn, args.in[I_MG], args.in[I_MU], args.in[I_MD], (unsigned char*)Wmgu, (unsigned char*)Wmd); moe_cvt_load(tA, vA, tid); }
              moe_cvt_process(tB, vB, scrb, tid);
              it = itn;
          } }
        quant_rows_i8(Wgu, Wgu8, cmax_gu, tab_sw, 2 * FF, gw, NGW, lane);
        quant_rows_i8(Wqkv, Wqkv8, cmax_gu + 2 * FF, tab_sw + 2 * FF, QKVD, gw, NGW, lane);
        quant_rows_i8(Win, Win8, cmax_gu + 2 * FF + QKVD, tab_sw + 2 * FF + QKVD, D, gw, NGW, lane);
        if (G > 64) { if (bx >= 64) rms_phase<true>(args.in[I_X], args.in[I_MIXN], Hb, (bx - 64) * NWAVES + wave, (G - 64) * NWAVES, lane, tab_sa); }
        else rms_phase<true>(args.in[I_X], args.in[I_MIXN], Hb, gw, NGW, lane, tab_sa);
        }
        if (BOTH(1)) GRID_BAR();
    }
#undef CVT_RUN
#undef CVT_DECODE

    if (IN(2)) { REP(2) {
        pg8::DenseSched S; S.init(Hb, (const bf16_t*)Wqkv8, T, QKVD, D / 2, D / 2, G, bx);
        pg8::EpiBf16i8 E{QKV, QKVD, tab_sa, tab_sw + 2 * FF};
        pg8::gemm_phase<pg8::EpiBf16i8, pg8::DenseSched, 2>(lds + RING_OFF, pg8::Gemm{D / 2, D / 2, D / 128}, S, E);
        }
        if (BOTH(2)) GRID_BAR();
    }


    if (IN(4)) { REP(4) {
        LAS float* tab = (LAS float*)(lds + 65536);
        for (int i = tid; i < 16 * 384; i += NWAVES * 64) {
            const int h = i / 384, r = (i - h * 384) - 192; float v = 0.f;
            if (r >= -128 && r <= 128) { const int n = r < 0 ? -r : r; int large = 2 + (31 - __builtin_clz((unsigned)(n * n) | 1u)); large = large < 15 ? large : 15;
                const int bucket = (r > 0 ? 16 : 0) + (n < 8 ? n : large); v = args.in[I_RELB][bucket * NH + h] * LOG2E; }
            tab[i] = v;
        }
        __syncthreads();
        const int g = wave >> 1, qh = wave & 1, r = lane & 31, h = lane >> 5;
        const f32x4 kg0 = *(const f32x4*)(args.in[I_KG] + (tid & 15) * 8), kg1 = *(const f32x4*)(args.in[I_KG] + (tid & 15) * 8 + 4);
        const float qsc = 0.08838834764831845f * LOG2E;
        const unsigned xr = ((r & 3u) << 2) | ((r >> 2) & 3u);
        const int tq = (lane & 15) >> 2, tp = lane & 3, tblk = (lane >> 4) & 1;
        for (int it = bx; it < BATCH * NKV * (SEQ / 64); it += G) {
            const int b = it >> 9, kvh = (it >> 7) & 3, qb = it & 127;
            const int q0 = qb * 64, ks0 = q0 - 128;
            const int c_lo = ks0 < 0 ? ((-ks0) >> 6) : 0;
            int c_hi = (SEQ - 1 - ks0) >> 6; c_hi = c_hi > 4 ? 4 : c_hi;
            const int hq = kvh * 4 + g;
            const size_t tokbase = (size_t)b * SEQ;
            const int qpos = q0 + 32 * qh + r;
            u32x4 kr[2], vr[2];
#define ATT_LOAD(c) do { _Pragma("unroll") for (int _i = 0; _i < 2; ++_i) { const int _p = tid + 512 * _i, _key = _p >> 4, _ch = _p & 15; \
                const bf16_t* _kp = QKV + (tokbase + (ks0 + 64 * (c) + _key)) * QKVD + D + kvh * HD + _ch * 8; kr[_i] = *(const u32x4*)_kp; vr[_i] = *(const u32x4*)(_kp + NKV * HD); } } while (0)
#define ATT_STORE(buf) do { _Pragma("unroll") for (int _i = 0; _i < 2; ++_i) { const int _p = tid + 512 * _i, _key = _p >> 4, _ch = _p & 15; \
                const unsigned _o = (unsigned)(buf) * 32768u + (unsigned)(_key >> 5) * 8192u + off_b((unsigned)(_key & 31), (unsigned)_ch); \
                const u32x4 _w = kr[_i]; float _ss = (bf_lo(_w.x) * bf_lo(_w.x) + bf_hi(_w.x) * bf_hi(_w.x)) + (bf_lo(_w.y) * bf_lo(_w.y) + bf_hi(_w.y) * bf_hi(_w.y)) + (bf_lo(_w.z) * bf_lo(_w.z) + bf_hi(_w.z) * bf_hi(_w.z)) + (bf_lo(_w.w) * bf_lo(_w.w) + bf_hi(_w.w) * bf_hi(_w.w)); \
                _ss += __shfl_xor(_ss, 1); _ss += __shfl_xor(_ss, 2); _ss += __shfl_xor(_ss, 4); _ss += __shfl_xor(_ss, 8);            \
                const float _rs = 1.0f / sqrtf(_ss * (1.f / HD) + EPS); const f32x4 _g0 = kg0 * _rs, _g1 = kg1 * _rs; \
                u32x4 _kn; _kn.x = pk2(bf_lo(_w.x) * _g0.x, bf_hi(_w.x) * _g0.y); _kn.y = pk2(bf_lo(_w.y) * _g0.z, bf_hi(_w.y) * _g0.w); _kn.z = pk2(bf_lo(_w.z) * _g1.x, bf_hi(_w.z) * _g1.y); _kn.w = pk2(bf_lo(_w.w) * _g1.z, bf_hi(_w.w) * _g1.w); \
                *(LAS u32x4*)(lds + _o) = _kn; *(LAS u32x4*)(lds + 16384u + _o) = vr[_i]; } } while (0)
            ATT_LOAD(c_lo);
            bf16x8 qf[8];
            { const bf16_t* qp = QKV + (tokbase + qpos) * QKVD + hq * HD + 8 * h;
#pragma unroll
              for (int s = 0; s < 8; ++s) qf[s] = *(const bf16x8*)(qp + 16 * s);
              float ss = 0.f;
#pragma unroll
              for (int s = 0; s < 8; ++s) { const u32x4 w = __builtin_bit_cast(u32x4, qf[s]);
                  ss += (bf_lo(w.x) * bf_lo(w.x) + bf_hi(w.x) * bf_hi(w.x)) + (bf_lo(w.y) * bf_lo(w.y) + bf_hi(w.y) * bf_hi(w.y)) + (bf_lo(w.z) * bf_lo(w.z) + bf_hi(w.z) * bf_hi(w.z)) + (bf_lo(w.w) * bf_lo(w.w) + bf_hi(w.w) * bf_hi(w.w)); }
              ss += __shfl_xor(ss, 32);
              const float rsq = qsc / sqrtf(ss * (1.f / HD) + EPS);
              const float* qgp = args.in[I_QG] + 8 * h;
#pragma unroll
              for (int s = 0; s < 8; ++s) { const u32x4 w = __builtin_bit_cast(u32x4, qf[s]); const f32x4 ga = *(const f32x4*)(qgp + 16 * s) * rsq, gb = *(const f32x4*)(qgp + 16 * s + 4) * rsq;
                  u32x4 o; o.x = pk2(bf_lo(w.x) * ga.x, bf_hi(w.x) * ga.y); o.y = pk2(bf_lo(w.y) * ga.z, bf_hi(w.y) * ga.w); o.z = pk2(bf_lo(w.z) * gb.x, bf_hi(w.z) * gb.y); o.w = pk2(bf_lo(w.w) * gb.z, bf_hi(w.w) * gb.w);
                  qf[s] = __builtin_bit_cast(bf16x8, o); } }
            f32x16 O[4];
#pragma unroll
            for (int c = 0; c < 4; ++c)
#pragma unroll
                for (int i = 0; i < 16; ++i) O[c][i] = 0.f;
            float m_run = args.in[I_SINK][hq] * LOG2E, l_run = (h == 0) ? 1.0f : 0.0f;
            ATT_STORE(0);
            __syncthreads();
            for (int c = c_lo; c <= c_hi; ++c) {
                const int cur = (c - c_lo) & 1;
                if (c < c_hi) ATT_LOAD(c + 1);
                const LAS unsigned char* kb = lds + (unsigned)cur * 32768u; const LAS unsigned char* vb = kb + 16384;
#pragma unroll
                for (int kt = 0; kt < 2; ++kt) {
                    const int kspan0 = 64 * c + 32 * kt, qs = 128 + 32 * qh;
                    if (kspan0 + 31 < qs - 128 || kspan0 > qs + 31 + 128) continue;
                    f32x16 sacc;
#pragma unroll
                    for (int i = 0; i < 16; ++i) sacc[i] = 0.f;
#pragma unroll
                    for (int s = 0; s < 8; ++s) { const bf16x8 kf = *(const LAS bf16x8*)(kb + kt * 8192 + 256u * r + 16u * ((unsigned)(2 * s + h) ^ xr));
                        sacc = __builtin_amdgcn_mfma_f32_32x32x16_bf16(kf, qf[s], sacc, 0, 0, 0); }
                    const int ib = kspan0 + 4 * h - (qs + r) + 192;
                    const LAS float* tb = tab + hq * 384 + ib;
                    float mx = -3.0e38f;
#pragma unroll
                    for (int i = 0; i < 16; ++i) { const int d = (i & 3) + 8 * (i >> 2); const int rel = ib + d - 192; const float bv = tb[d];
                        const float sv = (rel >= -128 && rel <= 128) ? sacc[i] + bv : -1.0e30f; sacc[i] = sv; mx = fmaxf(mx, sv); }
                    mx = fmaxf(mx, __shfl_xor(mx, 32));
                    const float m_new = fmaxf(m_run, mx);
                    if (__any(m_new > m_run)) {
                        const float alpha = __builtin_amdgcn_exp2f(m_run - m_new); m_run = m_new; l_run *= alpha;
#pragma unroll
                        for (int cc = 0; cc < 4; ++cc)
#pragma unroll
                            for (int i = 0; i < 16; ++i) O[cc][i] *= alpha; }
                    float ps = 0.f;
#pragma unroll
                    for (int i = 0; i < 16; ++i) { const float p = __builtin_amdgcn_exp2f(sacc[i] - m_run); sacc[i] = p; ps += p; }
                    l_run += ps;
                    bf16x8 pf[2];
#pragma unroll
                    for (int s2 = 0; s2 < 2; ++s2) { u32x4 w; w.x = pk2(sacc[8 * s2 + 0], sacc[8 * s2 + 1]); w.y = pk2(sacc[8 * s2 + 2], sacc[8 * s2 + 3]); w.z = pk2(sacc[8 * s2 + 4], sacc[8 * s2 + 5]); w.w = pk2(sacc[8 * s2 + 6], sacc[8 * s2 + 7]);
                        pf[s2] = __builtin_bit_cast(bf16x8, w); }
#pragma unroll
                    for (int cc = 0; cc < 4; ++cc)
#pragma unroll
                        for (int s2 = 0; s2 < 2; ++s2) {
                            const unsigned row0 = 16u * s2 + 4u * h + tq, ch = 4u * cc + 2u * tblk + (tp >> 1);
                            const s16x4 lo4 = tr_read(vb + kt * 8192 + off_b(row0, ch) + 8u * (tp & 1));
                            const s16x4 hi4 = tr_read(vb + kt * 8192 + off_b(row0 + 8u, ch) + 8u * (tp & 1));
                            const bf16x8 vf = __builtin_shufflevector(lo4, hi4, 0, 1, 2, 3, 4, 5, 6, 7);
                            O[cc] = __builtin_amdgcn_mfma_f32_32x32x16_bf16(vf, pf[s2], O[cc], 0, 0, 0);
                        }
                }
                if (c < c_hi) ATT_STORE(cur ^ 1);
                __syncthreads();
            }
#undef ATT_LOAD
#undef ATT_STORE
            const float linv = 1.0f / (l_run + __shfl_xor(l_run, 32));
            unsigned char* op = (unsigned char*)AO + (tokbase + qpos) * D + hq * HD + 4 * h;
#pragma unroll
            for (int cc = 0; cc < 4; ++cc)
#pragma unroll
                for (int ig = 0; ig < 4; ++ig) *(unsigned*)(op + 32 * cc + 8 * ig) = pk4_fp8(O[cc][4 * ig + 0] * linv, O[cc][4 * ig + 1] * linv, O[cc][4 * ig + 2] * linv, O[cc][4 * ig + 3] * linv);
        }
        }
        if (BOTH(4)) GRID_BAR();
    }

    if (IN(5)) { REP(5) {
        pg8::DenseSched S; S.init(AO, Wo, T, D, D / 2, D / 2, G, bx);
        pg8::EpiRes E{args.in[I_X], OUT, D, W8_INV};
        pg8::gemm_phase<pg8::EpiRes, pg8::DenseSched, 1>(lds + RING_OFF, pg8::Gemm{D / 2, D / 2, D / 128}, S, E);
        }
        if (BOTH(5)) GRID_BAR();
    }
    if (IN(6)) { REP(6) {
        rms_phase<true>(OUT, args.in[I_FFNN], Hb, gw, NGW, lane, tab_sa);
        quant_rows_i8(Wpt, Wpt8, cmax_gu + 2 * FF + QKVD + D, tab_sw + 2 * FF + QKVD + D, D, gw, NGW, lane);
        }
        if (BOTH(6)) GRID_BAR();
    }
    if (IN(7)) { REP(7) {
        pg8::DenseSched S; S.init(Hb, (const bf16_t*)Wgu8, T, 2 * FF, D / 2, D / 2, G, bx);
        pg8::EpiSwiGLUi8 E{ACT, FF, FF / 128, tab_sa, tab_sw, 1};
        pg8::gemm_phase<pg8::EpiSwiGLUi8, pg8::DenseSched, 2>(lds + RING_OFF, pg8::Gemm{D / 2, D / 2, D / 128}, S, E);
        }
        if (BOTH(7)) GRID_BAR();
    }
    if (IN(8)) { REP(8) {
        pg8::DenseSched S; S.init(ACT, Wd, T, D, FF / 2, FF / 2, G, bx);
        pg8::EpiRes E{OUT, OUT, D, W8_INV};
        pg8::gemm_phase<pg8::EpiRes, pg8::DenseSched, 1>(lds + RING_OFF, pg8::Gemm{FF / 2, FF / 2, FF / 128, FF / 128, FF / 128}, S, E);
        }
        if (BOTH(8)) GRID_BAR();
    }
    if (IN(9)) { REP(9) {
        rms_phase<true>(OUT, args.in[I_MIXN] + D, Hb, gw, NGW, lane, tab_sa);
        }
        if (BOTH(9)) GRID_BAR();
    }
    if (IN(10)) { REP(10) {
        pg8::DenseSched S; S.init(Hb, (const bf16_t*)Win8, T, D, D / 2, D / 2, G, bx);
        pg8::EpiBf16i8 E{Ub, D, tab_sa, tab_sw + 2 * FF + QKVD};
        pg8::gemm_phase<pg8::EpiBf16i8, pg8::DenseSched, 2>(lds + RING_OFF, pg8::Gemm{D / 2, D / 2, D / 128}, S, E);
        }
        if (BOTH(10)) GRID_BAR();
    }
    if (IN(11)) { REP(11) {
        LAS float* rmx = (LAS float*)(lds + RING_OFF);
        for (int idx = bx * (NWAVES * 64) + tid; idx < (T / 16) * (D / 8); idx += G * NWAVES * 64) {
            const int rb = idx >> 8, c8 = idx & 255, grp = c8 >> 6, h = 1 << grp, rbl = tid >> 8;
            const int t0 = rb * 16, b = t0 >> 13, tt0 = t0 & (SEQ - 1);
            const bf16_t* up = Ub + ((size_t)b * SEQ) * D + c8 * 8;
            float a[8];
#pragma unroll
            for (int i = 0; i < 8; ++i) a[i] = 0.f;
            { int lo_ = tt0 - h; lo_ = lo_ < 0 ? 0 : lo_; int hi_ = tt0 + h; hi_ = hi_ > SEQ ? SEQ : hi_;
              for (int j = lo_; j < hi_; ++j) { const u32x4 w = *(const u32x4*)(up + (size_t)j * D);
                  a[0] += bf_lo(w.x); a[1] += bf_hi(w.x); a[2] += bf_lo(w.y); a[3] += bf_hi(w.y); a[4] += bf_lo(w.z); a[5] += bf_hi(w.z); a[6] += bf_lo(w.w); a[7] += bf_hi(w.w); } }
            u32x4 dres[16];
#pragma unroll
            for (int sb = 0; sb < 2; ++sb) {
                const int tb = tt0 + 8 * sb;
                u32x4 wc[8], wa[8], wsb[8];
#pragma unroll
                for (int j = 0; j < 8; ++j) { const int tt = tb + j; int ra = tt + h; ra = ra > SEQ - 1 ? SEQ - 1 : ra; int rs_ = tt - h; rs_ = rs_ < 0 ? 0 : rs_;
                    wc[j] = *(const u32x4*)(up + (size_t)tt * D); wa[j] = *(const u32x4*)(up + (size_t)ra * D); wsb[j] = *(const u32x4*)(up + (size_t)rs_ * D); }
#pragma unroll
                for (int j = 0; j < 8; ++j) { const int tt = tb + j; int lo_ = tt - h; lo_ = lo_ < 0 ? 0 : lo_; int hi_ = tt + h; hi_ = hi_ > SEQ ? SEQ : hi_;
                    const float inv = 1.0f / (float)(hi_ - lo_); const u32x4 w = wc[j];
                    const float d0 = a[0] * inv - bf_lo(w.x), d1 = a[1] * inv - bf_hi(w.x), d2 = a[2] * inv - bf_lo(w.y), d3 = a[3] * inv - bf_hi(w.y), d4 = a[4] * inv - bf_lo(w.z), d5 = a[5] * inv - bf_hi(w.z), d6 = a[6] * inv - bf_lo(w.w), d7 = a[7] * inv - bf_hi(w.w);
                    u32x4 o; o.x = pk2(d0, d1); o.y = pk2(d2, d3); o.z = pk2(d4, d5); o.w = pk2(d6, d7); dres[8 * sb + j] = o;
                    const float mxr = wave_max(fmaxf(fmaxf(fmaxf(fabsf(d0), fabsf(d1)), fmaxf(fabsf(d2), fabsf(d3))), fmaxf(fmaxf(fabsf(d4), fabsf(d5)), fmaxf(fabsf(d6), fabsf(d7)))));
                    if (lane == 0) rmx[(rbl * 16 + 8 * sb + j) * 4 + grp] = mxr;
                    const float ma = (tt + h < SEQ) ? 1.f : 0.f, ms = (tt - h >= 0) ? 1.f : 0.f; const u32x4 p = wa[j], q = wsb[j];
                    a[0] += ma * bf_lo(p.x) - ms * bf_lo(q.x); a[1] += ma * bf_hi(p.x) - ms * bf_hi(q.x); a[2] += ma * bf_lo(p.y) - ms * bf_lo(q.y); a[3] += ma * bf_hi(p.y) - ms * bf_hi(q.y);
                    a[4] += ma * bf_lo(p.z) - ms * bf_lo(q.z); a[5] += ma * bf_hi(p.z) - ms * bf_hi(q.z); a[6] += ma * bf_lo(p.w) - ms * bf_lo(q.w); a[7] += ma * bf_hi(p.w) - ms * bf_hi(q.w); }
                asm volatile("" ::: "memory");
            }
            __syncthreads();
            unsigned char* dp8 = (unsigned char*)DDb + ((size_t)b * SEQ + tt0) * D + c8 * 8;
#pragma unroll
            for (int j = 0; j < 16; ++j) { const f32x4 m4 = *(const LAS f32x4*)(rmx + (rbl * 16 + j) * 4); const float am = fmaxf(fmaxf(fmaxf(m4.x, m4.y), fmaxf(m4.z, m4.w)), 1e-30f), inv = 127.0f / am;
                const u32x4 w = dres[j]; u32x2 o;
                o.x = pk4_i8(__builtin_rintf(bf_lo(w.x) * inv), __builtin_rintf(bf_hi(w.x) * inv), __builtin_rintf(bf_lo(w.y) * inv), __builtin_rintf(bf_hi(w.y) * inv));
                o.y = pk4_i8(__builtin_rintf(bf_lo(w.z) * inv), __builtin_rintf(bf_hi(w.z) * inv), __builtin_rintf(bf_lo(w.w) * inv), __builtin_rintf(bf_hi(w.w) * inv));
                *(u32x2*)(dp8 + (size_t)j * D) = o;
                if (c8 == 0) tab_sa[t0 + j] = am * (1.0f / 127.0f); }
            __syncthreads();
        }
        }
        if (BOTH(11)) GRID_BAR();
    }
    if (IN(13)) { REP(13) {
        pg8::DenseSched S; S.init(DDb, (const bf16_t*)Wpt8, T, D, D / 2, D / 2, G, bx);
        pg8::EpiResI8 E{OUT, OUT, D, tab_sa, tab_sw + 2 * FF + QKVD + D};
        pg8::gemm_phase<pg8::EpiResI8, pg8::DenseSched, 2>(lds + RING_OFF, pg8::Gemm{D / 2, D / 2, D / 128}, S, E);
        }
        if (BOTH(13)) GRID_BAR();
    }
    if (IN(14)) { REP(14) {
        LAS float* rwl = (LAS float*)(lds + RING_OFF);
        LAS int* lcnt = (LAS int*)(lds + RING_OFF + 65536);
        const float* rw = args.in[I_RW]; const float* rb = args.in[I_RB];
        for (int rr = tid; rr < D; rr += NWAVES * 64) { const f32x4 a = *(const f32x4*)(rw + rr * 8), b2 = *(const f32x4*)(rw + rr * 8 + 4);
            rwl[0 * D + rr] = a.x; rwl[1 * D + rr] = a.y; rwl[2 * D + rr] = a.z; rwl[3 * D + rr] = a.w; rwl[4 * D + rr] = b2.x; rwl[5 * D + rr] = b2.y; rwl[6 * D + rr] = b2.z; rwl[7 * D + rr] = b2.w; }
        if (tid < 8) lcnt[tid] = 0;
        __syncthreads();
        const float* gain = args.in[I_FFNN] + D;
        if (G == 256) {
            f32x4 gg[8], va[8], vb[8];
#pragma unroll
            for (int j = 0; j < 8; ++j) gg[j] = ((const f32x4*)gain + lane)[64 * j];
#define P13_ROW(v, t_) do { const int t = (t_); float s = 0.f; \
                _Pragma("unroll") for (int j = 0; j < 8; ++j) s += (v[j].x * v[j].x + v[j].y * v[j].y) + (v[j].z * v[j].z + v[j].w * v[j].w); \
                const float rs = 1.0f / sqrtf(wave_sum(s) * (1.f / D) + EPS); \
                unsigned* o4 = (unsigned*)((unsigned char*)Hb + (size_t)t * D) + lane;        \
                _Pragma("unroll") for (int j = 0; j < 8; ++j) { v[j] = v[j] * rs * gg[j]; o4[64 * j] = pk4_fp8(v[j].x, v[j].y, v[j].z, v[j].w); } \
                float lg[8]; \
                _Pragma("unroll") for (int e = 0; e < 8; ++e) { float a = 0.f; \
                    _Pragma("unroll") for (int j = 0; j < 8; ++j) { const f32x4 w4 = *(const LAS f32x4*)(rwl + e * D + 4 * (lane + 64 * j)); a += (v[j].x * w4.x + v[j].y * w4.y) + (v[j].z * w4.z + v[j].w * w4.w); } \
                    lg[e] = wave_sum(a) + rb[e]; } \
                int e0 = 0; float v0 = lg[0]; \
                _Pragma("unroll") for (int e = 1; e < 8; ++e) if (lg[e] > v0) { v0 = lg[e]; e0 = e; } \
                int e1 = -1; float v1 = -3.0e38f; \
                _Pragma("unroll") for (int e = 0; e < 8; ++e) if (e != e0 && lg[e] > v1) { v1 = lg[e]; e1 = e; } \
                const float w0 = 1.0f / (1.0f + __expf(v1 - v0)), w1 = 1.0f - w0; \
                if (lane == 0) { tab_te[t] = e0 | (e1 << 8); tab_tw[2 * t] = w0; tab_tw[2 * t + 1] = w1; __hip_atomic_fetch_add(&lcnt[e0], 1, __ATOMIC_RELAXED, __HIP_MEMORY_SCOPE_WORKGROUP); __hip_atomic_fetch_add(&lcnt[e1], 1, __ATOMIC_RELAXED, __HIP_MEMORY_SCOPE_WORKGROUP); } } while (0)
            const int tw0 = 64 * bx + 8 * wave;
            rms_load(va, OUT, tw0, lane);
            for (int i = 0; i < 8; i += 2) {
                rms_load(vb, OUT, tw0 + i + 1, lane);
                P13_ROW(va, tw0 + i);
                if (i + 2 < 8) rms_load(va, OUT, tw0 + i + 2, lane);
                P13_ROW(vb, tw0 + i + 1);
            }
#undef P13_ROW
        }
        __syncthreads();
        if (tid < 8) tab_cnt[bx * 8 + tid] = lcnt[tid];
        }
        if (BOTH(14)) GRID_BAR();
    }
    if (IN(15)) { REP(15) {
        LAS int* arr = (LAS int*)(lds + RING_OFF);
        LAS int* ltot = arr + 2048; LAS int* lpre = ltot + 8; LAS int* lseg = lpre + 8; LAS int* lslot = lseg + 16;
        if (G == 256) {
            if (tid < 256) {
#pragma unroll
                for (int e = 0; e < 8; ++e) arr[e * 256 + tid] = tab_cnt[tid * 8 + e];
            }
            __syncthreads();
            { const int e = wave; int tot = 0, pre = 0;
#pragma unroll
              for (int k = 0; k < 4; ++k) { const int idx = lane * 4 + k; const int v = arr[e * 256 + idx]; tot += v; pre += (idx < bx) ? v : 0; }
              tot = wave_sum_i(tot); pre = wave_sum_i(pre);
              if (lane == 0) { ltot[e] = tot; lpre[e] = pre; } }
            __syncthreads();
            if (tid == 0) { int s = 0; for (int e = 0; e < 8; ++e) { lseg[e] = s; s += ((ltot[e] + 255) >> 8) << 8; } lseg[8] = s; }
            __syncthreads();
            if (bx == 0 && tid < 160) { const int slot = tid * 256; int e = 0;
#pragma unroll
                for (int k = 0; k < 8; ++k) if (slot >= lseg[k] && slot < lseg[k + 1]) e = k;
                tab_tile[tid] = e; if (tid == 0) tab_tile[255] = lseg[8] >> 8; }
            if (wave == 0) {
                const int t = 64 * bx + lane; const int pk = tab_te[t]; const int e0 = pk & 255, e1 = pk >> 8; int s0 = 0, s1 = 0;
                const unsigned long long lt = (1ull << lane) - 1ull;
#pragma unroll
                for (int e = 0; e < 8; ++e) { const int base = lseg[e] + lpre[e]; const unsigned long long m0 = __ballot(e0 == e), m1 = __ballot(e1 == e);
                    const int r0 = __popcll(m0 & lt), r1 = __popcll(m0) + __popcll(m1 & lt);
                    if (e0 == e) s0 = base + r0; if (e1 == e) s1 = base + r1; }
                tab_slot[2 * t] = s0; tab_slot[2 * t + 1] = s1; tab_wslot[s0] = tab_tw[2 * t]; tab_wslot[s1] = tab_tw[2 * t + 1];
                lslot[2 * lane] = s0; lslot[2 * lane + 1] = s1;
            }
            __syncthreads();
            for (int i = 0; i < 8; ++i) { const int tl = 8 * wave + i, t = 64 * bx + tl; const int s0 = lslot[2 * tl], s1 = lslot[2 * tl + 1];
                const u32x4* src = (const u32x4*)((unsigned char*)Hb + (size_t)t * D) + lane; u32x4* d0 = (u32x4*)((unsigned char*)HS + (size_t)s0 * D) + lane; u32x4* d1 = (u32x4*)((unsigned char*)HS + (size_t)s1 * D) + lane;
#pragma unroll
                for (int k = 0; k < 2; ++k) { const u32x4 w = src[64 * k]; d0[64 * k] = w; d1[64 * k] = w; } }
        }
        }
        if (BOTH(15)) GRID_BAR();
    }
    if (IN(16)) { REP(16) {
        LAS int* lt = (LAS int*)(lds + LTAB_OFF);
        if (tid < 256) lt[tid] = tab_tile[tid];
        __syncthreads();
        int nM = __builtin_amdgcn_readfirstlane(lt[255]); nM = nM < 0 ? 0 : (nM > SLOTS_MAX / 256 ? SLOTS_MAX / 256 : nM);
        pg8::MoeSched S; S.init(HS, Wmgu, nM, 2 * FFE, D / 2, D / 2, lt, G, bx);
        pg8::EpiSwiGLU8 E{(unsigned char*)ACTM, FFE, W8_INV, FFE / 128};
        pg8::gemm_phase<pg8::EpiSwiGLU8, pg8::MoeSched, true>(lds + RING_OFF, pg8::Gemm{D / 2, D / 2, D / 128}, S, E);
        }
        if (BOTH(16)) GRID_BAR();
    }
    if (IN(17)) { REP(17) {
        LAS int* lt = (LAS int*)(lds + LTAB_OFF);
        if (tid < 256) lt[tid] = tab_tile[tid];
        __syncthreads();
        int nM = __builtin_amdgcn_readfirstlane(lt[255]); nM = nM < 0 ? 0 : (nM > SLOTS_MAX / 256 ? SLOTS_MAX / 256 : nM);
        const int nMain = nM < TAIL_PM0 ? nM : TAIL_PM0, R = nM - nMain;
        { pg8::MoeSched S; S.init(ACTM, Wmd, nMain, D, FFE / 2, FFE / 2, lt, G, bx);
          pg8::EpiRowScaleBf16 E{HS, D, tab_wslot, W8_INV};
          pg8::gemm_phase<pg8::EpiRowScaleBf16, pg8::MoeSched, true>(lds + RING_OFF, pg8::Gemm{FFE / 2, FFE / 2, FFE / 128, FFE / 128, FFE / 128}, S, E); }
        if (R > 0) { const int Sk = tail_split(R);
          pg8::MoeTailSched S; S.init(ACTM, Wmd, TAIL_PM0, R, Sk, D, FFE / 2, FFE / 2, lt, G, bx);
          pg8::EpiPartF32 E{(float*)(ws + WS_PART), tab_wslot, W8_INV};
          pg8::gemm_phase<pg8::EpiPartF32, pg8::MoeTailSched, true>(lds + RING_OFF, pg8::Gemm{FFE / 2, FFE / 2, (FFE / 128) / Sk, FFE / 128, FFE / 128}, S, E); }
        }
        if (BOTH(17)) GRID_BAR();
    }
    if (IN(18)) {
        const bool bad = (N_LAUNCHES == 1) && (__hip_atomic_load((unsigned*)(ws + WS_CTL) + CW_BAR + XB_TMO, RLX_AGENT) != 0u);
#define P17_LOAD(ya, yb, ov, t_, sa, sb) do { const int _t = (t_); const int _s0 = tab_slot[2 * _t], _s1 = tab_slot[2 * _t + 1]; sa = _s0; sb = _s1; \
            const f32x4* _op = (const f32x4*)(OUT + (size_t)_t * D) + 2 * lane; const u32x4* _y0 = (const u32x4*)(HS + (size_t)_s0 * D) + lane; const u32x4* _y1 = (const u32x4*)(HS + (size_t)_s1 * D) + lane; \
            _Pragma("unroll") for (int k = 0; k < 4; ++k) { ya[k] = _y0[64 * k]; yb[k] = _y1[64 * k]; ov[2 * k] = _op[128 * k]; ov[2 * k + 1] = _op[128 * k + 1]; } } while (0)
#define P17_TAIL(yv, sl) do { if ((sl) >= TAIL_PM0 * 256) { const int _ut0 = (((sl) >> 8) - TAIL_PM0) * 8, _r = (sl) & 255; \
            _Pragma("unroll") for (int k = 0; k < 4; ++k) { const int _col = 8 * lane + 512 * k; const float* _pp = PART + ((size_t)(_ut0 + (_col >> 8)) * Sk) * 65536 + _r * 256 + (_col & 255); \
                f32x4 _a0 = {0.f, 0.f, 0.f, 0.f}, _a1 = {0.f, 0.f, 0.f, 0.f}; for (int _kp = 0; _kp < Sk; ++_kp) { _a0 += *(const f32x4*)(_pp + (size_t)_kp * 65536); _a1 += *(const f32x4*)(_pp + (size_t)_kp * 65536 + 4); } \
                u32x4 _w; _w.x = pk2(_a0.x, _a0.y); _w.y = pk2(_a0.z, _a0.w); _w.z = pk2(_a1.x, _a1.y); _w.w = pk2(_a1.z, _a1.w); yv[k] = _w; } } } while (0)
#define P17_FIN(ya, yb, ov, t_, sa, sb) do { f32x4* _op = (f32x4*)(OUT + (size_t)(t_) * D) + 2 * lane; P17_TAIL(ya, sa); P17_TAIL(yb, sb); \
            _Pragma("unroll") for (int k = 0; k < 4; ++k) { const u32x4 a = ya[k], c = yb[k]; f32x4 o0 = ov[2 * k], o1 = ov[2 * k + 1]; \
                o0.x += bf_lo(a.x) + bf_lo(c.x); o0.y += bf_hi(a.x) + bf_hi(c.x); o0.z += bf_lo(a.y) + bf_lo(c.y); o0.w += bf_hi(a.y) + bf_hi(c.y); \
                o1.x += bf_lo(a.z) + bf_lo(c.z); o1.y += bf_hi(a.z) + bf_hi(c.z); o1.z += bf_lo(a.w) + bf_lo(c.w); o1.w += bf_hi(a.w) + bf_hi(c.w); \
                if (bad) { const float q = __builtin_nanf(""); o0 = (f32x4){q, q, q, q}; o1 = o0; } \
                _op[128 * k] = o0; _op[128 * k + 1] = o1; } } while (0)
        { u32x4 yaA[4], ybA[4], yaB[4], ybB[4]; f32x4 ovA[8], ovB[8]; int saA, sbA, saB, sbB;
          const float* PART = (const float*)(ws + WS_PART);
          int nMt = tab_tile[255]; nMt = nMt > SLOTS_MAX / 256 ? SLOTS_MAX / 256 : nMt; const int Sk = tail_split(nMt - TAIL_PM0);
          int t = gw;
          if (t < T) { P17_LOAD(yaA, ybA, ovA, t, saA, sbA);
            for (;;) {
                const int tn = t + NGW; if (tn < T) P17_LOAD(yaB, ybB, ovB, tn, saB, sbB);
                P17_FIN(yaA, ybA, ovA, t, saA, sbA);
                if (tn >= T) break;
                t = tn + NGW; if (t < T) P17_LOAD(yaA, ybA, ovA, t, saA, sbA);
                P17_FIN(yaB, ybB, ovB, tn, saB, sbB);
                if (t >= T) break;
            } } }
#undef P17_LOAD
#undef P17_FIN
#undef P17_TAIL
    }
#undef IN
#undef BOTH
#undef GRID_BAR
}

extern "C" void kernel_launch(void* const* d_in, const int* in_sizes, int n_in, void* d_out, int out_size, void* d_ws, size_t ws_size, hipStream_t stream) {
    static int grid = 0;
    if (grid == 0) {
        if (n_in != 21 || in_sizes[0] != T * D || out_size != T * D || ws_size < WS_END) { fprintf(stderr, "kernel_launch: unexpected shapes (n_in %d, in0 %d, out %d, ws %zu need %zu); nothing launched\n", n_in, n_in > 0 ? in_sizes[0] : -1, out_size, ws_size, (size_t)WS_END); grid = -1; return; }
        int dev = 0, cus = 0, per_cu = 0;
        if (hipGetDevice(&dev) != hipSuccess || hipDeviceGetAttribute(&cus, hipDeviceAttributeMultiprocessorCount, dev) != hipSuccess) { fprintf(stderr, "kernel_launch: device query failed\n"); grid = -1; return; }
        if (hipFuncSetAttribute((const void*)fwd_kernel, hipFuncAttributeMaxDynamicSharedMemorySize, LDS_BYTES) != hipSuccess) { fprintf(stderr, "kernel_launch: hipFuncSetAttribute failed\n"); grid = -1; return; }
        if (hipOccupancyMaxActiveBlocksPerMultiprocessor(&per_cu, (const void*)fwd_kernel, NWAVES * 64, LDS_BYTES) != hipSuccess || per_cu < 1) fprintf(stderr, "kernel_launch: note: occupancy query reports %d\n", per_cu);
        (void)hipGetLastError();
        grid = cus;
        if (grid != 256) fprintf(stderr, "kernel_launch: %d CUs; the MoE routing phases need a 256-workgroup grid\n", grid);
    }
    if (grid < 0) return;
    if (hipMemsetAsync((char*)d_ws + WS_CTL, 0, CTL_ZERO_BYTES, stream) != hipSuccess) { fprintf(stderr, "kernel_launch: memset failed\n"); return; }
    Args a{};
    for (int i = 0; i < 21; ++i) a.in[i] = (const float*)d_in[i];
    a.out = (float*)d_out; a.ws = (unsigned char*)d_ws;
    for (int li = 0; li < N_LAUNCHES; ++li) {
        a.ph_lo = (N_LAUNCHES == 1) ? 0 : li; a.ph_hi = (N_LAUNCHES == 1) ? NPH : li + 1;
        hipLaunchKernelGGL(fwd_kernel, dim3(grid), dim3(NWAVES * 64), LDS_BYTES, stream, a);
        const hipError_t le = hipPeekAtLastError();
        if (le != hipSuccess) { fprintf(stderr, "kernel_launch: launch %d failed: %s\n", li, hipGetErrorName(le)); break; }
    }
}
```
